# Optimizing an MI355X kernel written in HIP

```python
import math
import jax, jax.numpy as jnp
from jax import lax
import numpy as np

D_MODEL = 2048
BATCH = 2
SEQ = 8192
DEPTH = 4

N_MIXERS = 2
HEAD_DIM = 64
N_HEADS = D_MODEL // HEAD_DIM
SWA_KV_HEADS = 8
SWA_GROUP = N_HEADS // SWA_KV_HEADS
WINDOW = 128
BLOCK = 128
ROPE_THETA = 500000.0
ROT_DIM = HEAD_DIM // 4
D_FF = int(math.ceil((8 * D_MODEL / 3) / 256) * 256)
N_SWA = (DEPTH + 1) // 2
N_FOX = DEPTH // 2
RMS_EPS = 1e-6

kernel_name = "hybrid_swa_sink_fox_swiglu_sandwich"


def rmsnorm(x, g):
    x32 = x.astype(jnp.float32)
    y = x32 * lax.rsqrt(jnp.mean(x32 * x32, axis=-1, keepdims=True) + RMS_EPS) * g.astype(jnp.float32)
    return y.astype(x.dtype)


def rotary_tables(positions, dtype):
    inv_freq = ROPE_THETA ** (-jnp.arange(0, ROT_DIM, 2, dtype=jnp.float32) / ROT_DIM)
    ang = positions.astype(jnp.float32)[..., None] * inv_freq
    return jnp.cos(ang)[:, :, None, :].astype(dtype), jnp.sin(ang)[:, :, None, :].astype(dtype)


def partial_rotary(x, cos, sin):
    xr, xp = x[..., :ROT_DIM], x[..., ROT_DIM:]
    x1, x2 = xr[..., :ROT_DIM // 2], xr[..., ROT_DIM // 2:]
    rot = jnp.concatenate([x1 * cos - x2 * sin, x2 * cos + x1 * sin], axis=-1)
    return jnp.concatenate([rot, xp], axis=-1)


def swa_sink_attention(h, w_in, sinks, w_out, cos, sin):
    B, S, _ = h.shape
    nblk = S // BLOCK
    qkv = h @ w_in
    qd, kd = N_HEADS * HEAD_DIM, SWA_KV_HEADS * HEAD_DIM
    q = qkv[..., :qd].reshape(B, S, N_HEADS, HEAD_DIM)
    k = qkv[..., qd:qd + kd].reshape(B, S, SWA_KV_HEADS, HEAD_DIM)
    v = qkv[..., qd + kd:].reshape(B, S, SWA_KV_HEADS, HEAD_DIM)
    q = partial_rotary(q, cos, sin)
    k = partial_rotary(k, cos, sin)

    qb = q.reshape(B, nblk, BLOCK, SWA_KV_HEADS, SWA_GROUP, HEAD_DIM)

    def band(t):
        tb = t.reshape(B, nblk, BLOCK, SWA_KV_HEADS, HEAD_DIM)
        prev = jnp.pad(tb[:, :-1], ((0, 0), (1, 0), (0, 0), (0, 0), (0, 0)))
        return jnp.concatenate([prev, tb], axis=2)

    kband, vband = band(k), band(v)
    scale = HEAD_DIM ** -0.5
    s = jnp.einsum('bnqkgd,bnskd->bnkgqs', qb, kband).astype(jnp.float32) * scale

    q_loc = jnp.arange(BLOCK)[:, None]
    s_loc = jnp.arange(2 * BLOCK)[None, :]
    rel = BLOCK + q_loc - s_loc
    in_win = (rel >= 0) & (rel < WINDOW)
    has_prev = (jnp.arange(nblk) > 0)[:, None, None] | (s_loc >= BLOCK)[None]
    valid = (in_win[None] & has_prev)[None, :, None, None]
    s = jnp.where(valid, s, -jnp.inf)

    sink = sinks.astype(jnp.float32).reshape(SWA_KV_HEADS, SWA_GROUP)[None, None, :, :, None, None]
    m = jnp.maximum(jnp.max(s, axis=-1, keepdims=True), sink)
    p = jnp.exp(s - m)
    denom = jnp.sum(p, axis=-1, keepdims=True) + jnp.exp(sink - m)
    probs = (p / denom).astype(v.dtype)
    out = jnp.einsum('bnkgqs,bnskd->bnqkgd', probs, vband).reshape(B, S, N_HEADS * HEAD_DIM)
    return out @ w_out


def forgetting_attention(h, w_in, b_f, w_out):
    B, S, _ = h.shape
    nblk = S // BLOCK
    hd = N_HEADS * HEAD_DIM
    proj = h @ w_in
    q = proj[..., :hd].reshape(B, S, N_HEADS, HEAD_DIM)
    k = proj[..., hd:2 * hd].reshape(B, S, N_HEADS, HEAD_DIM)
    v = proj[..., 2 * hd:3 * hd].reshape(B, S, N_HEADS, HEAD_DIM)
    f_logit = proj[..., 3 * hd:]
    log_f = jax.nn.log_sigmoid(f_logit.astype(jnp.float32) + b_f.astype(jnp.float32))
    c = jnp.transpose(jnp.cumsum(log_f, axis=1), (0, 2, 1))
    key_pos = jnp.arange(S)
    scale = HEAD_DIM ** -0.5

    def block(i):
        start = i * BLOCK
        qi = lax.dynamic_slice_in_dim(q, start, BLOCK, axis=1)
        ci = lax.dynamic_slice_in_dim(c, start, BLOCK, axis=2)
        s = jnp.einsum('bqhd,bshd->bhqs', qi, k).astype(jnp.float32) * scale
        s = s + ci[..., :, None] - c[:, :, None, :]
        t_pos = start + jnp.arange(BLOCK)
        s = jnp.where(key_pos[None, :] <= t_pos[:, None], s, -jnp.inf)
        p = jax.nn.softmax(s, axis=-1).astype(v.dtype)
        return jnp.einsum('bhqs,bshd->bqhd', p, v)

    out = lax.map(block, jnp.arange(nblk))
    out = jnp.transpose(out, (1, 0, 2, 3, 4)).reshape(B, S, hd)
    return out @ w_out


def swiglu_ffn(h, w_gate_up, w_down):
    gu = h @ w_gate_up
    gate, up = gu[..., :D_FF], gu[..., D_FF:]
    return (jax.nn.silu(gate) * up) @ w_down


def setup_inputs(seed: int = 0) -> dict:
    key = jax.random.key(seed)
    ks = jax.random.split(key, 10)
    f32 = jnp.float32
    x = jax.random.normal(ks[0], (BATCH, SEQ, D_MODEL), f32)
    positions = jnp.broadcast_to(jnp.arange(SEQ, dtype=jnp.int32), (BATCH, SEQ)).astype(jnp.int32)
    norm_gains = 1.0 + 0.05 * jax.random.normal(ks[1], (DEPTH, 4, D_MODEL), f32)
    swa_in_dim = (N_HEADS + 2 * SWA_KV_HEADS) * HEAD_DIM
    swa_w_in = jax.random.normal(ks[2], (N_SWA, D_MODEL, swa_in_dim), f32) * D_MODEL ** -0.5
    swa_sinks = 0.5 * jax.random.normal(ks[3], (N_SWA, N_HEADS), f32)
    swa_w_out = jax.random.normal(ks[4], (N_SWA, N_HEADS * HEAD_DIM, D_MODEL), f32) * (N_HEADS * HEAD_DIM) ** -0.5
    fox_in_dim = 3 * N_HEADS * HEAD_DIM + N_HEADS
    fox_w_in = jax.random.normal(ks[5], (N_FOX, D_MODEL, fox_in_dim), f32) * D_MODEL ** -0.5
    fox_b_f = 2.0 + 0.5 * jax.random.normal(ks[6], (N_FOX, N_HEADS), f32)
    fox_w_out = jax.random.normal(ks[7], (N_FOX, N_HEADS * HEAD_DIM, D_MODEL), f32) * (N_HEADS * HEAD_DIM) ** -0.5
    ffn_w_gate_up = jax.random.normal(ks[8], (DEPTH, D_MODEL, 2 * D_FF), f32) * D_MODEL ** -0.5
    ffn_w_down = jax.random.normal(ks[9], (DEPTH, D_FF, D_MODEL), f32) * D_FF ** -0.5
    return {"x": x, "positions": positions, "norm_gains": norm_gains,
            "swa_w_in": swa_w_in, "swa_sinks": swa_sinks, "swa_w_out": swa_w_out,
            "fox_w_in": fox_w_in, "fox_b_f": fox_b_f, "fox_w_out": fox_w_out,
            "ffn_w_gate_up": ffn_w_gate_up, "ffn_w_down": ffn_w_down}


def reference(x, positions, norm_gains, swa_w_in, swa_sinks, swa_w_out,
              fox_w_in, fox_b_f, fox_w_out, ffn_w_gate_up, ffn_w_down):
    cos, sin = rotary_tables(positions, x.dtype)
    for i in range(DEPTH):
        g = norm_gains[i]
        h = rmsnorm(x, g[0])
        if i % N_MIXERS == 0:
            j = i // N_MIXERS
            y = swa_sink_attention(h, swa_w_in[j], swa_sinks[j], swa_w_out[j], cos, sin)
        else:
            j = i // N_MIXERS
            y = forgetting_attention(h, fox_w_in[j], fox_b_f[j], fox_w_out[j])
        x = x + rmsnorm(y, g[1])
        h = rmsnorm(x, g[2])
        y = swiglu_ffn(h, ffn_w_gate_up[i], ffn_w_down[i])
        x = x + rmsnorm(y, g[3])
    return x
```

```cpp
#include <hip/hip_runtime.h>
#include <hip/hip_cooperative_groups.h>
#include <cstdio>
#include <cstdint>
#include <cmath>
namespace cg = cooperative_groups;
namespace pg8 {
#define PG8_LAS __attribute__((address_space(3)))
typedef unsigned short bf16_t;
typedef short bf16x8 __attribute__((ext_vector_type(8)));
typedef float f32x4 __attribute__((ext_vector_type(4)));
typedef unsigned u32x4 __attribute__((ext_vector_type(4)));
constexpr int BM = 256, BK = 64, HALF = 128, HTB = HALF * BK * 2  , STAGE_BYTES = 8 * HTB, NXCD = 8, WGM = 8;

__host__ __device__ __forceinline__ int lds_byte(int r, int c) { const int st = (r >> 4) * 2 + (c >> 5), rr = r & 15, cc = c & 31, ob = rr * 64 + cc * 2; return st * 1024 + (ob ^ (((ob >> 9) & 1) << 5)); }
__host__ __device__ __forceinline__ void stage_rc(int b, int& R, int& C) { const int st = b / 1024, sb = b % 1024, swz = sb ^ (((sb >> 9) & 1) << 5); R = (st >> 1) * 16 + swz / 64; C = (st & 1) * 32 + (swz % 64) / 2; }
__host__ __device__ __forceinline__ int perm32(int rho) { const int n = rho >> 4, i = rho & 15; return 8 * (i >> 2) + 4 * n + (i & 3); }

struct Unit { int pm, pn; };
struct Gemm { const bf16_t* A; const bf16_t* Bt; int M, N, K; };

struct StaticOrder {
    int nM, nN, nwg, G, c;
    __host__ __device__ void init(int M, int N, int G_, int c_) { nM = M / BM; nN = N / BM; nwg = nM * nN; G = G_; c = c_; }
    __host__ __device__ bool next(int i, Unit& u) const {
        const long L = (long)i * G + c; if (L >= nwg) return false;
        int wgid = (int)L; { const int q = nwg / NXCD, r = nwg % NXCD, xcd = wgid % NXCD, off = wgid / NXCD; wgid = (xcd < r ? xcd * (q + 1) : r * (q + 1) + (xcd - r) * q) + off; }
        const int nig = WGM * nN, gid = wgid / nig, fm = gid * WGM, gsz = (nM - fm) < WGM ? (nM - fm) : WGM;
        u.pm = fm + ((wgid % nig) % gsz); u.pn = (wgid % nig) / gsz; return true;
    }
    __device__ __forceinline__ void a_ready(const Unit&) const {}
    __device__ __forceinline__ void done(const Unit&) const {}
};

__device__ __forceinline__ unsigned cvt_pk_bf16(float lo, float hi) { unsigned r; asm volatile("v_cvt_pk_bf16_f32 %0, %1, %2" : "=v"(r) : "v"(lo), "v"(hi)); return r; }
typedef float f32x2 __attribute__((ext_vector_type(2)));
struct EpiQKV {
    static constexpr bool PERM = true, AFTER_DRAIN = false;
    bf16_t* O; int ldc; int ntile_main; float* G;
    __device__ __forceinline__ void plain(const f32x4 (&acc)[2][2][4][2], const Unit& u, int wr, int wc, int fr, int fq) const {
        const int row0 = u.pm * BM + wr * 64 + fr, col0 = u.pn * BM + wc * 32 + 8 * fq;
#pragma unroll
        for (int ai = 0; ai < 2; ++ai)
#pragma unroll
            for (int m = 0; m < 4; ++m) { bf16_t* rowp = O + (size_t)(row0 + ai * HALF + m * 16) * ldc + col0;
#pragma unroll
                for (int bj = 0; bj < 2; ++bj) { const f32x4 v0 = acc[ai][bj][m][0], v1 = acc[ai][bj][m][1];
                    u32x4 w; w.x = cvt_pk_bf16(v0[0], v0[1]); w.y = cvt_pk_bf16(v0[2], v0[3]); w.z = cvt_pk_bf16(v1[0], v1[1]); w.w = cvt_pk_bf16(v1[2], v1[3]);
                    *(u32x4*)(rowp + bj * HALF) = w; } }
    }
    __device__ __forceinline__ void operator()(const f32x4 (&acc)[2][2][4][2], const Unit& u, int wr, int wc, int fr, int fq) const {
        const int row0 = u.pm * BM + wr * 64 + fr;
        if (u.pn < ntile_main) {
            const int col0 = u.pn * BM + wc * 32 + 8 * fq;
            const bool rot = (ntile_main > 4096) && (u.pn < 10) && ((wc & 1) == 0);
            const float sg = fq == 0 ? -1.f : 1.f;
#pragma unroll
            for (int ai = 0; ai < 2; ++ai)
#pragma unroll
                for (int m = 0; m < 4; ++m) { const int row = row0 + ai * HALF + m * 16; bf16_t* rowp = O + (size_t)row * ldc + col0;
                    f32x4 c0 = {1.f, 1.f, 1.f, 1.f}, c1 = c0, s0 = {0.f, 0.f, 0.f, 0.f}, s1 = s0;
                    if (rot) { const float* cp = G + (size_t)row * 8; c0 = *(const f32x4*)cp; c1 = *(const f32x4*)(cp + 4); s0 = *(const f32x4*)(cp + 131072); s1 = *(const f32x4*)(cp + 131072 + 4); }
#pragma unroll
                    for (int bj = 0; bj < 2; ++bj) { f32x4 v0 = acc[ai][bj][m][0], v1 = acc[ai][bj][m][1];
                        if (rot) { f32x4 q0, q1;
#pragma unroll
                            for (int e = 0; e < 4; ++e) { q0[e] = __shfl_xor(v0[e], 16); q1[e] = __shfl_xor(v1[e], 16); }
                            if (fq < 2) { v0 = v0 * c0 + sg * q0 * s0; v1 = v1 * c1 + sg * q1 * s1; } }
                        u32x4 w; w.x = cvt_pk_bf16(v0[0], v0[1]); w.y = cvt_pk_bf16(v0[2], v0[3]); w.z = cvt_pk_bf16(v1[0], v1[1]); w.w = cvt_pk_bf16(v1[2], v1[3]);
                        *(u32x4*)(rowp + bj * HALF) = w; } }
        } else if (wc == 0) {
#pragma unroll
            for (int ai = 0; ai < 2; ++ai)
#pragma unroll
                for (int m = 0; m < 4; ++m) { float* gp = G + (size_t)(row0 + ai * HALF + m * 16) * 32 + 8 * fq;
                    *(f32x4*)gp = acc[ai][0][m][0]; *(f32x4*)(gp + 4) = acc[ai][0][m][1]; }
        }
    }
};
struct EpiF32 {
    static constexpr bool PERM = false, AFTER_DRAIN = false;
    float* Y; int ldc;
    __device__ __forceinline__ void operator()(const f32x4 (&acc)[2][2][4][2], const Unit& u, int wr, int wc, int fr, int fq) const {
        const int row0 = u.pm * BM + wr * 64 + fr, col0 = u.pn * BM + wc * 32 + 4 * fq;
#pragma unroll
        for (int ai = 0; ai < 2; ++ai)
#pragma unroll
            for (int m = 0; m < 4; ++m) { float* rowp = Y + (size_t)(row0 + ai * HALF + m * 16) * ldc + col0;
#pragma unroll
                for (int bj = 0; bj < 2; ++bj)
#pragma unroll
                    for (int n = 0; n < 2; ++n) *(f32x4*)(rowp + bj * HALF + n * 16) = acc[ai][bj][m][n]; }
    }
};
struct EpiSwiGLU {
    static constexpr bool PERM = true, AFTER_DRAIN = false;
    bf16_t* Hout; int ldc;
    static __device__ __forceinline__ float sw(float g, float up) { return g * __builtin_amdgcn_rcpf(1.0f + __builtin_amdgcn_exp2f(-1.4426950408889634f * g)) * up; }
    __device__ __forceinline__ void operator()(const f32x4 (&acc)[2][2][4][2], const Unit& u, int wr, int wc, int fr, int fq) const {
        const int row0 = u.pm * BM + wr * 64 + fr, col0 = u.pn * HALF + wc * 32 + 8 * fq;
#pragma unroll
        for (int ai = 0; ai < 2; ++ai)
#pragma unroll
            for (int m = 0; m < 4; ++m) { bf16_t* rowp = Hout + (size_t)(row0 + ai * HALF + m * 16) * ldc + col0;
                const f32x4 g0 = acc[ai][0][m][0], g1 = acc[ai][0][m][1], u0 = acc[ai][1][m][0], u1 = acc[ai][1][m][1];
                u32x4 w; w.x = cvt_pk_bf16(sw(g0[0], u0[0]), sw(g0[1], u0[1])); w.y = cvt_pk_bf16(sw(g0[2], u0[2]), sw(g0[3], u0[3]));
                w.z = cvt_pk_bf16(sw(g1[0], u1[0]), sw(g1[1], u1[1])); w.w = cvt_pk_bf16(sw(g1[2], u1[2]), sw(g1[3], u1[3]));
                *(u32x4*)rowp = w; }
    }
};

struct EpiAny {
    static constexpr bool AFTER_DRAIN = false;
    int mode; bool PERM; unsigned char* O; int ldc; int ntile_main; float* G;
    __device__ __forceinline__ void operator()(const f32x4 (&acc)[2][2][4][2], const Unit& u, int wr, int wc, int fr, int fq) const {
        if (mode == 0) { EpiQKV e{(bf16_t*)O, ldc, ntile_main, G}; e(acc, u, wr, wc, fr, fq); }
        else if (mode == 1) { EpiQKV e{(bf16_t*)O, ldc, 1 << 20, nullptr}; e.plain(acc, u, wr, wc, fr, fq); }
        else { EpiSwiGLU e{(bf16_t*)O, ldc}; e(acc, u, wr, wc, fr, fq); }
    }
};

template <class Epi, class Sched, bool ALIGN_EPI = false, bool SP2 = false>
__device__ __forceinline__ void gemm_phase(PG8_LAS unsigned char* lds, const Gemm g, const Sched& S, const Epi& E) {
    const int tid = threadIdx.x, wid = __builtin_amdgcn_readfirstlane(tid >> 6), lane = tid & 63, wr = wid >> 2, wc = wid & 3, fr = lane & 15, fq = lane >> 4;
    const int K = g.K, nt = K / BK;
    unsigned voffA[2], voffB[2];
#pragma unroll
    for (int i = 0; i < 2; ++i) { int R, C; stage_rc(tid * 16 + i * 8192, R, C); const int Rb = E.PERM ? ((R & ~31) + perm32(R & 31)) : R;
        voffA[i] = (unsigned)(R * K + C) * 2u; voffB[i] = (unsigned)(Rb * K + C) * 2u; }
    const size_t kstep = (size_t)(BK * 2);
    const size_t hstep = (size_t)HALF * K * 2;
    const size_t tstep = 2 * hstep;
    const unsigned ldsw = (unsigned)wid * 1024u;
    const int aoff = lds_byte(wr * 64 + fr, fq * 8), boff = lds_byte(wc * 32 + fr, fq * 8);
#define PG8_SA(b, h) (((b) * 2 + (h)) * HTB)
#define PG8_SB(b, h) ((4 + (b) * 2 + (h)) * HTB)
#define PG8_STAGE(bufoff, gbase, voff) do { _Pragma("unroll") for (int _i = 0; _i < 2; ++_i) \
        __builtin_amdgcn_global_load_lds((const unsigned*)((const char*)(gbase) + (voff)[_i]), (PG8_LAS unsigned*)(lds + (bufoff) + ldsw + _i * 8192), 16, 0, 0); } while (0)
#define PG8_LDA(dst, b, h) do { _Pragma("unroll") for (int m = 0; m < 4; ++m) _Pragma("unroll") for (int k = 0; k < 2; ++k) dst[m][k] = *(const PG8_LAS bf16x8*)(lds + PG8_SA(b, h) + aoff + m * 2048 + k * 1024); } while (0)
#define PG8_LDB(dst, b, h) do { _Pragma("unroll") for (int n = 0; n < 2; ++n) _Pragma("unroll") for (int k = 0; k < 2; ++k) dst[n][k] = *(const PG8_LAS bf16x8*)(lds + PG8_SB(b, h) + boff + n * 2048 + k * 1024); } while (0)
#define PG8_MMA(ai, bj, At, Bt) do { __builtin_amdgcn_s_setprio(1); _Pragma("unroll") for (int m = 0; m < 4; ++m) _Pragma("unroll") for (int n = 0; n < 2; ++n) _Pragma("unroll") for (int k = 0; k < 2; ++k) \
        acc[ai][bj][m][n] = __builtin_amdgcn_mfma_f32_16x16x32_bf16(Bt[n][k], At[m][k], acc[ai][bj][m][n], 0, 0, 0); __builtin_amdgcn_s_setprio(0); } while (0)
#define PG8_WAIT_V(n) asm volatile("s_waitcnt vmcnt(" #n ")" ::: "memory")
#define PG8_WAIT_L(n) asm volatile("s_waitcnt lgkmcnt(" #n ")" ::: "memory")
#define PG8_BAR __builtin_amdgcn_s_barrier()
#define PG8_SCHED __builtin_amdgcn_sched_barrier(0)
    Unit cur, nxt; int ui = 0;
    if (!S.next(0, cur)) return;
    f32x4 acc[2][2][4][2];
#pragma unroll
    for (int a = 0; a < 2; ++a)
#pragma unroll
        for (int b = 0; b < 2; ++b)
#pragma unroll
            for (int m = 0; m < 4; ++m)
#pragma unroll
                for (int n = 0; n < 2; ++n) acc[a][b][m][n] = (f32x4){0.f, 0.f, 0.f, 0.f};
    bf16x8 At[4][2], B0[2][2], B1[2][2];
    const char* cA = (const char*)g.A + (size_t)cur.pm * tstep; const char* cB = (const char*)g.Bt + (size_t)cur.pn * tstep;
    S.a_ready(cur);
    if constexpr (SP2) {
        PG8_STAGE(PG8_SB(0, 0), cB, voffB); PG8_STAGE(PG8_SB(0, 1), cB + hstep, voffB); PG8_STAGE(PG8_SA(0, 0), cA, voffA); PG8_STAGE(PG8_SA(0, 1), cA + hstep, voffA);
        if (wr == 1) PG8_BAR;
        PG8_WAIT_V(2); PG8_BAR;
        PG8_STAGE(PG8_SB(1, 0), cB + kstep, voffB); PG8_STAGE(PG8_SA(1, 0), cA + kstep, voffA); PG8_STAGE(PG8_SB(1, 1), cB + hstep + kstep, voffB);
        PG8_WAIT_V(6); PG8_BAR;
    } else {
        PG8_STAGE(PG8_SB(0, 0), cB, voffB); PG8_STAGE(PG8_SA(0, 0), cA, voffA); PG8_STAGE(PG8_SB(0, 1), cB + hstep, voffB); PG8_STAGE(PG8_SA(0, 1), cA + hstep, voffA);
        if (wr == 1) PG8_BAR;
        PG8_WAIT_V(4); PG8_BAR;
        PG8_STAGE(PG8_SB(1, 0), cB + kstep, voffB); PG8_STAGE(PG8_SA(1, 0), cA + kstep, voffA); PG8_STAGE(PG8_SB(1, 1), cB + hstep + kstep, voffB);
        PG8_WAIT_V(6); PG8_BAR;
    }
    for (;;) {
        const bool has_next = S.next(ui + 1, nxt);
        const char* nA = has_next ? (const char*)g.A + (size_t)nxt.pm * tstep : cA; const char* nB = has_next ? (const char*)g.Bt + (size_t)nxt.pn * tstep : cB;
        for (int t = 0; t < nt; t += 2) {
            const bool last = (t == nt - 2);
            const char* a1 = cA + (size_t)(t + 1) * kstep;
            const char* a2 = last ? nA : cA + (size_t)(t + 2) * kstep; const char* b2 = last ? nB : cB + (size_t)(t + 2) * kstep;
            const char* a3 = a2 + kstep; const char* b3 = b2 + kstep;
            if (last && has_next) S.a_ready(nxt);
            if constexpr (SP2) {
            PG8_LDB(B0, 0, 0); PG8_LDB(B1, 0, 1); PG8_SCHED; PG8_LDA(At, 0, 0); PG8_STAGE(PG8_SA(1, 1), a1 + hstep, voffA);
            PG8_WAIT_V(8); PG8_WAIT_L(0); PG8_BAR; PG8_MMA(0, 0, At, B0); PG8_MMA(0, 1, At, B1); PG8_BAR; PG8_SCHED;
            PG8_LDA(At, 0, 1); PG8_STAGE(PG8_SB(0, 0), b2, voffB); PG8_STAGE(PG8_SB(0, 1), b2 + hstep, voffB); PG8_STAGE(PG8_SA(0, 0), a2, voffA);
            PG8_WAIT_V(8); PG8_WAIT_L(0); PG8_BAR; PG8_MMA(1, 0, At, B0); PG8_MMA(1, 1, At, B1); PG8_BAR; PG8_SCHED;
            PG8_LDB(B0, 1, 0); PG8_LDB(B1, 1, 1); PG8_SCHED; PG8_LDA(At, 1, 0); PG8_STAGE(PG8_SA(0, 1), a2 + hstep, voffA);
            PG8_WAIT_V(8); PG8_WAIT_L(0); PG8_BAR; PG8_MMA(0, 0, At, B0); PG8_MMA(0, 1, At, B1); PG8_BAR; PG8_SCHED;
            PG8_LDA(At, 1, 1); PG8_STAGE(PG8_SB(1, 0), b3, voffB); PG8_STAGE(PG8_SB(1, 1), b3 + hstep, voffB); PG8_STAGE(PG8_SA(1, 0), a3, voffA);
            PG8_WAIT_V(8); PG8_WAIT_L(0); PG8_BAR; PG8_MMA(1, 0, At, B0); PG8_MMA(1, 1, At, B1); PG8_BAR; PG8_SCHED;
            } else {
            PG8_LDB(B0, 0, 0); PG8_SCHED; PG8_LDA(At, 0, 0); PG8_STAGE(PG8_SA(1, 1), a1 + hstep, voffA);
            PG8_WAIT_L(8); PG8_BAR; PG8_WAIT_L(0); PG8_MMA(0, 0, At, B0); PG8_BAR; PG8_SCHED;
            PG8_LDB(B1, 0, 1); PG8_STAGE(PG8_SB(0, 0), b2, voffB);
            PG8_BAR; PG8_WAIT_L(0); PG8_MMA(0, 1, At, B1); PG8_BAR;
            PG8_LDA(At, 0, 1); PG8_STAGE(PG8_SA(0, 0), a2, voffA);
            PG8_BAR; PG8_WAIT_L(0); PG8_MMA(1, 0, At, B0); PG8_BAR; PG8_SCHED;
            PG8_STAGE(PG8_SB(0, 1), b2 + hstep, voffB);
            PG8_WAIT_V(6); PG8_BAR; PG8_MMA(1, 1, At, B1); PG8_BAR;
            PG8_LDB(B0, 1, 0); PG8_SCHED; PG8_LDA(At, 1, 0); PG8_STAGE(PG8_SA(0, 1), a2 + hstep, voffA);
            PG8_WAIT_L(8); PG8_BAR; PG8_WAIT_L(0); PG8_MMA(0, 0, At, B0); PG8_BAR; PG8_SCHED;
            PG8_LDB(B1, 1, 1); PG8_STAGE(PG8_SB(1, 0), b3, voffB);
            PG8_BAR; PG8_WAIT_L(0); PG8_MMA(0, 1, At, B1); PG8_BAR;
            PG8_LDA(At, 1, 1); PG8_STAGE(PG8_SA(1, 0), a3, voffA);
            PG8_BAR; PG8_WAIT_L(0); PG8_MMA(1, 0, At, B0); PG8_BAR; PG8_SCHED;
            PG8_STAGE(PG8_SB(1, 1), b3 + hstep, voffB);
            PG8_WAIT_V(6); PG8_BAR; PG8_MMA(1, 1, At, B1); PG8_BAR;
            }
        }
        if constexpr (ALIGN_EPI) { if (wr == 0) PG8_BAR; }
        if constexpr (!Epi::AFTER_DRAIN) { E(acc, cur, wr, wc, fr, fq); S.done(cur); }
        if (!has_next) break;
#pragma unroll
        for (int a = 0; a < 2; ++a)
#pragma unroll
            for (int b = 0; b < 2; ++b)
#pragma unroll
                for (int m = 0; m < 4; ++m)
#pragma unroll
                    for (int n = 0; n < 2; ++n) acc[a][b][m][n] = (f32x4){0.f, 0.f, 0.f, 0.f};
        cur = nxt; cA = nA; cB = nB; ++ui;
        if constexpr (ALIGN_EPI) { if (wr == 1) PG8_BAR; }
    }
    PG8_WAIT_V(0);
    if constexpr (!ALIGN_EPI) { if (wr == 0) PG8_BAR; }
    PG8_BAR;
    if constexpr (Epi::AFTER_DRAIN) { E.fused(acc, cur, wr, wc, fr, fq, lds, wid, lane); S.done(cur); }
#undef PG8_SA
#undef PG8_SB
#undef PG8_STAGE
#undef PG8_LDA
#undef PG8_LDB
#undef PG8_MMA
#undef PG8_WAIT_V
#undef PG8_WAIT_L
#undef PG8_BAR
#undef PG8_SCHED
}
}
#define PG8_ALIGN true
#ifndef PROBE_ST
#define PROBE_ST -1
#define PROBE_LAYER 1
#define PROBE_NSYNC 1
#define PROBE_DUP 0
#define PROBE_PH 8
#define PROBE_FOXREP 1
#define PROBE_FOXVAR 0
#define PROBE_PROREP 1
#define PROBE_SWAREP 1
#endif
#define PG8_SP2 true
constexpr int NWAVES = 8;
constexpr int BATCH = 2, SEQ = 8192, DM = 2048, M = BATCH * SEQ, NH = 32, HD = 64, KVH = 8, DFF = 5632, DEPTH = 4;
constexpr int N_SWA_IN = 3072, N_FOX_IN = 6176, N_FOX_PAD = 6400, N_FOX_MAIN = 6144, N_GU = 2 * DFF;
constexpr float RMS_EPS = 1e-6f, LOG2E = 1.4426950408889634f, C2 = 0.125f * 1.4426950408889634f;
constexpr size_t MiB = 1u << 20; constexpr int RING_BYTES_C = 131072;
constexpr size_t WS_CTL = 0;
constexpr int MISC_OFF = RING_BYTES_C + 320;
constexpr size_t WS_ROPE = 1 * MiB, WS_GATE = 2 * MiB, WS_CUM = 4 * MiB  , WS_KPART = 7 * MiB;
constexpr size_t WS_WSI = 8 * MiB, WS_WSO = 32 * MiB, WS_WFI = 48 * MiB, WS_WFO = 98 * MiB, WS_WGU = 114 * MiB, WS_WDN = 290 * MiB;
constexpr size_t WS_XN = 378 * MiB, WS_QKV = 442 * MiB, WS_HB = WS_QKV, WS_AO = 634 * MiB, WS_Y = 698 * MiB, WS_END = 826 * MiB;
static_assert(WS_WSI + 2ull * N_SWA_IN * DM * 2 <= WS_WSO && WS_WSO + 2ull * DM * DM * 2 <= WS_WFI && WS_WFI + 2ull * N_FOX_PAD * DM * 2 <= WS_WFO && WS_WFO + 2ull * DM * DM * 2 <= WS_WGU
              && WS_WGU + 4ull * N_GU * DM * 2 <= WS_WDN && WS_WDN + 4ull * DM * DFF * 2 <= WS_XN && WS_XN + (size_t)M * DM * 2 <= WS_QKV && WS_QKV + (size_t)M * N_FOX_MAIN * 2 <= WS_AO
              && WS_HB + (size_t)M * DFF * 2 <= WS_AO && WS_AO + (size_t)M * DM * 2 <= WS_Y && WS_Y + (size_t)M * DM * 2 <= WS_END, "d_ws map");
constexpr int RING_BYTES = 131072, LDS_BYTES = 147456;

#define LAS __attribute__((address_space(3)))
typedef unsigned short bf16;
typedef unsigned v4u __attribute__((ext_vector_type(4)));
typedef unsigned v2u __attribute__((ext_vector_type(2)));
typedef float f32x4 __attribute__((ext_vector_type(4)));
typedef float f32x16 __attribute__((ext_vector_type(16)));
typedef short bf16x8 __attribute__((ext_vector_type(8)));
typedef short s16x4 __attribute__((ext_vector_type(4)));
#define LDS_WAIT() asm volatile("s_waitcnt lgkmcnt(0)" ::: "memory")
__device__ __forceinline__ unsigned f2bf(float f) { unsigned u = __builtin_bit_cast(unsigned, f); return (u + 0x7fffu + ((u >> 16) & 1u)) >> 16; }
__device__ __forceinline__ unsigned pk2(float lo, float hi) { return f2bf(lo) | (f2bf(hi) << 16); }
typedef float f32x2_t __attribute__((ext_vector_type(2))); typedef __bf16 bf16x2_t __attribute__((ext_vector_type(2)));
__device__ __forceinline__ unsigned cvtpk(float lo, float hi) { f32x2_t v = {lo, hi}; bf16x2_t b = __builtin_convertvector(v, bf16x2_t); return __builtin_bit_cast(unsigned, b); }
__device__ __forceinline__ float bf2f(unsigned short b) { return __builtin_bit_cast(float, (unsigned)b << 16); }
__device__ __forceinline__ float wave_sum(float v) {
#pragma unroll
    for (int o = 1; o < 64; o <<= 1) v += __shfl_xor(v, o);
    return v;
}

template <int N> __device__ __forceinline__ float row_shl(float v) {
    return __int_as_float(__builtin_amdgcn_update_dpp(0, __float_as_int(v), 0x100 + N, 0xf, 0xf, true));
}
__device__ __forceinline__ int opaque_tid() { int t = threadIdx.x; asm volatile("" : "+v"(t)); return t; }
__device__ __forceinline__ void transpose_item(const float* W, int K, int N, bf16* WT, int k0, int n0, int drow0, LAS float* scr, int lane) {
#pragma unroll 8
    for (int i = 0; i < 32; ++i) { const int kk = 2 * i + (lane >> 5); scr[kk * 33 + (lane & 31)] = __builtin_nontemporal_load(W + (size_t)(k0 + kk) * N + n0 + (lane & 31)); }
    LDS_WAIT(); asm volatile("" ::: "memory");
    const int c = lane & 7;
#pragma unroll
    for (int j = 0; j < 4; ++j) { const int n = (lane >> 3) + 8 * j; const LAS float* s = scr + (8 * c) * 33 + n;
        v4u o; o.x = pk2(s[0 * 33], s[1 * 33]); o.y = pk2(s[2 * 33], s[3 * 33]); o.z = pk2(s[4 * 33], s[5 * 33]); o.w = pk2(s[6 * 33], s[7 * 33]);
        __builtin_nontemporal_store(o, (v4u*)(WT + (size_t)(drow0 + n) * K + k0 + 8 * c)); }
    LDS_WAIT(); asm volatile("" ::: "memory");
}
template <bool GU>
__device__ __forceinline__ void transpose_family(const float* W, int nmat, int K, int N, bf16* WT, size_t dstride, LAS float* scr, int gw, int NGW, int lane) {
    const int nblk = N / 32, per = (K / 64) * nblk, total = nmat * per;
    for (int it = gw; it < total; it += NGW) {
        const int mi = it / per, r = it % per, kb = r / nblk, nb = r % nblk, n0 = nb * 32;
        int drow0 = n0;
        if (GU) { const int j = n0 < DFF ? n0 : n0 - DFF; drow0 = (j >> 7) * 256 + (n0 < DFF ? 0 : 128) + (j & 127); }
        transpose_item(W + (size_t)mi * K * N, K, N, WT + (size_t)mi * dstride, kb * 64, n0, drow0, scr, lane);
    }
}
__device__ __forceinline__ void prenorm_rows(const float* X, const float* g, bf16* XN, int vcu, int NGW) {
    const int tid = opaque_tid(), lane = tid & 63, gw = vcu * NWAVES + __builtin_amdgcn_readfirstlane(tid >> 6);
    for (int m = gw; m < M; m += NGW) {
        const f32x4* xr = (const f32x4*)(X + (size_t)m * DM) + lane;
        f32x4 x[8]; float ss = 0.f;
#pragma unroll
        for (int j = 0; j < 8; ++j) { x[j] = __builtin_nontemporal_load(xr + 64 * j); ss += (x[j].x * x[j].x + x[j].y * x[j].y) + (x[j].z * x[j].z + x[j].w * x[j].w); }
        const float r = 1.0f / sqrtf(wave_sum(ss) * (1.0f / DM) + RMS_EPS);
        v2u* o8 = (v2u*)(XN + (size_t)m * DM) + lane;
#pragma unroll
        for (int j = 0; j < 8; ++j) { const f32x4 gg = ((const f32x4*)g)[lane + 64 * j]; v2u w; w.x = pk2(x[j].x * r * gg.x, x[j].y * r * gg.y); w.y = pk2(x[j].z * r * gg.z, x[j].w * r * gg.w); o8[64 * j] = w; }
    }
}
__device__ __forceinline__ void post_rows(const float* Xsrc, const bf16* Y, const float* g1, const float* g2, float* Xdst, bf16* XN, bool do_next, int vcu, int NGW) {
    const int tid = opaque_tid(), lane = tid & 63, gw = vcu * NWAVES + __builtin_amdgcn_readfirstlane(tid >> 6);
    v2u yw[8], ywn[8]; f32x4 x[8], xn[8], gg1[8], gg2[8];
#pragma unroll
    for (int j = 0; j < 8; ++j) { gg1[j] = ((const f32x4*)g1)[lane + 64 * j]; gg2[j] = do_next ? ((const f32x4*)g2)[lane + 64 * j] : gg1[j]; }
    if (gw < M) {
        const v2u* yr = (const v2u*)(Y + (size_t)gw * DM) + lane; const f32x4* xr = (const f32x4*)(Xsrc + (size_t)gw * DM) + lane;
#pragma unroll
        for (int j = 0; j < 8; ++j) { ywn[j] = __builtin_nontemporal_load(yr + 64 * j); xn[j] = __builtin_nontemporal_load(xr + 64 * j); }
    }
    for (int m = gw; m < M; m += NGW) {
#pragma unroll
        for (int j = 0; j < 8; ++j) { yw[j] = ywn[j]; x[j] = xn[j]; }
        if (m + NGW < M) {
            const v2u* yr = (const v2u*)(Y + (size_t)(m + NGW) * DM) + lane; const f32x4* xr = (const f32x4*)(Xsrc + (size_t)(m + NGW) * DM) + lane;
#pragma unroll
            for (int j = 0; j < 8; ++j) { ywn[j] = __builtin_nontemporal_load(yr + 64 * j); xn[j] = __builtin_nontemporal_load(xr + 64 * j); }
        }
        f32x4* xo = (f32x4*)(Xdst + (size_t)m * DM) + lane;
        f32x4 y[8]; float ss = 0.f;
#pragma unroll
        for (int j = 0; j < 8; ++j) { const v2u w = yw[j]; y[j] = (f32x4){bf2f((unsigned short)(w.x & 0xffffu)), bf2f((unsigned short)(w.x >> 16)), bf2f((unsigned short)(w.y & 0xffffu)), bf2f((unsigned short)(w.y >> 16))};
            ss += (y[j].x * y[j].x + y[j].y * y[j].y) + (y[j].z * y[j].z + y[j].w * y[j].w); }
        const float r1 = 1.0f / sqrtf(wave_sum(ss) * (1.0f / DM) + RMS_EPS);
        float s2 = 0.f;
#pragma unroll
        for (int j = 0; j < 8; ++j) { const f32x4 gg = gg1[j]; x[j] = x[j] + y[j] * r1 * gg; s2 += (x[j].x * x[j].x + x[j].y * x[j].y) + (x[j].z * x[j].z + x[j].w * x[j].w); __builtin_nontemporal_store(x[j], xo + 64 * j); }
        if (do_next) {
            const float r2 = 1.0f / sqrtf(wave_sum(s2) * (1.0f / DM) + RMS_EPS);
            v2u* o8 = (v2u*)(XN + (size_t)m * DM) + lane;
#pragma unroll
            for (int j = 0; j < 8; ++j) { const f32x4 gg = gg2[j]; v2u w; w.x = cvtpk(x[j].x * r2 * gg.x, x[j].y * r2 * gg.y); w.y = cvtpk(x[j].z * r2 * gg.z, x[j].w * r2 * gg.w); o8[64 * j] = w; }
        }
    }
}

constexpr int KS_PITCH = 144, VT_PITCH = 136, OFF_VT = 9216, OFF_BS = 17920, ABUF = 18432;
__device__ __forceinline__ float max3f(float a, float b, float c) { float r; asm("v_max3_f32 %0, %1, %2, %3" : "=v"(r) : "v"(a), "v"(b), "v"(c)); return r; }
__device__ __forceinline__ float max2f(float a, float b) { float r; asm("v_max_f32_e32 %0, %1, %2" : "=v"(r) : "v"(a), "v"(b)); return r; }
__device__ __forceinline__ float xhalf_max(float v) { auto rr = __builtin_amdgcn_permlane32_swap(__float_as_uint(v), __float_as_uint(v), false, false); return max2f(__uint_as_float(rr[0]), __uint_as_float(rr[1])); }
__device__ __forceinline__ bf16x8 scale_q(v4u w) {
    const unsigned ww[4] = {w.x, w.y, w.z, w.w}; unsigned r[4];
#pragma unroll
    for (int i = 0; i < 4; ++i) r[i] = cvtpk(bf2f((unsigned short)(ww[i] & 0xffffu)) * 0.125f, bf2f((unsigned short)(ww[i] >> 16)) * 0.125f);
    v4u o; o.x = r[0]; o.y = r[1]; o.z = r[2]; o.w = r[3]; return __builtin_bit_cast(bf16x8, o);
}
template <int MODE, bool WINDOW>
__device__ __forceinline__ void attn_tile(const LAS unsigned char* buf, const bf16x8* qr, f32x16* o, float& m, float& l, int qpos, int kbase, int r32, int hi, const bool CAUSAL) {
    const LAS unsigned char* Ks = buf; const LAS unsigned char* Vt = buf + OFF_VT; const LAS float* Bs = (const LAS float*)(buf + OFF_BS);
    f32x16 p0, p1;
    if (MODE == 1) {
#pragma unroll
        for (int g = 0; g < 4; ++g) { const f32x4 b0 = *(const LAS f32x4*)(Bs + 8 * g + 4 * hi), b1 = *(const LAS f32x4*)(Bs + 32 + 8 * g + 4 * hi);
#pragma unroll
            for (int e = 0; e < 4; ++e) { p0[4 * g + e] = b0[e]; p1[4 * g + e] = b1[e]; } }
    } else {
#pragma unroll
        for (int r = 0; r < 16; ++r) { p0[r] = 0.f; p1[r] = 0.f; }
    }
#pragma unroll
    for (int d0 = 0; d0 < 4; ++d0) {
        const bf16x8 a0 = *(const LAS bf16x8*)(Ks + r32 * KS_PITCH + d0 * 32 + hi * 16);
        const bf16x8 a1 = *(const LAS bf16x8*)(Ks + (32 + r32) * KS_PITCH + d0 * 32 + hi * 16);
        p0 = __builtin_amdgcn_mfma_f32_32x32x16_bf16(a0, qr[d0], p0, 0, 0, 0);
        p1 = __builtin_amdgcn_mfma_f32_32x32x16_bf16(a1, qr[d0], p1, 0, 0, 0);
    }
    if (CAUSAL || WINDOW) {
#pragma unroll
        for (int r = 0; r < 16; ++r) {
            const int kv0 = kbase + (r & 3) + 8 * (r >> 2) + 4 * hi, kv1 = kv0 + 32;
            bool v0 = true, v1 = true;
            if (CAUSAL) { v0 = kv0 <= qpos; v1 = kv1 <= qpos; }
            if (WINDOW) { v0 = v0 && (qpos - kv0 < 128); v1 = v1 && (qpos - kv1 < 128); }
            p0[r] = v0 ? p0[r] : -INFINITY; p1[r] = v1 ? p1[r] : -INFINITY;
        }
    }
    asm volatile("s_nop 15\n\ts_nop 7" : "+v"(p0), "+v"(p1));
    float mxa = max3f(p0[0], p1[0], p0[1]), mxb = max3f(p1[1], p0[2], p1[2]);
#pragma unroll
    for (int r = 3; r < 15; r += 2) { mxa = max3f(mxa, p0[r], p1[r]); mxb = max3f(mxb, p0[r + 1], p1[r + 1]); }
    mxa = max3f(mxa, p0[15], p1[15]);
    const float mx = xhalf_max(max2f(mxa, mxb));
    bf16x8 va[4], vb[4];
#pragma unroll
    for (int g = 0; g < 4; ++g) {
        const LAS unsigned char* vp = Vt + (32 * (g & 1) + r32) * VT_PITCH + (16 * (g >> 1) + 4 * hi) * 2;
        const s16x4 lo = *(const LAS s16x4*)vp, h4 = *(const LAS s16x4*)(vp + 16), lo2 = *(const LAS s16x4*)(vp + 64), h42 = *(const LAS s16x4*)(vp + 80);
        va[g] = (bf16x8){lo[0], lo[1], lo[2], lo[3], h4[0], h4[1], h4[2], h4[3]};
        vb[g] = (bf16x8){lo2[0], lo2[1], lo2[2], lo2[3], h42[0], h42[1], h42[2], h42[3]};
    }
    const float mn = max2f(m, mx);
    if (__any(mn > m)) {
        const float alpha = __builtin_amdgcn_exp2f((m - mn) * LOG2E);
        l *= alpha;
#pragma unroll
        for (int r = 0; r < 16; ++r) { o[0][r] *= alpha; o[1][r] *= alpha; }
    }
    m = mn;
    const float nm2 = -mn * LOG2E;
    float rs = 0.f;
#pragma unroll
    for (int r = 0; r < 16; ++r) { p0[r] = __builtin_amdgcn_exp2f(__builtin_fmaf(p0[r], LOG2E, nm2)); rs += p0[r]; }
    v4u pw0, pw1;
    pw0.x = cvtpk(p0[0], p0[1]); pw0.y = cvtpk(p0[2], p0[3]); pw0.z = cvtpk(p0[4], p0[5]); pw0.w = cvtpk(p0[6], p0[7]);
    pw1.x = cvtpk(p0[8], p0[9]); pw1.y = cvtpk(p0[10], p0[11]); pw1.z = cvtpk(p0[12], p0[13]); pw1.w = cvtpk(p0[14], p0[15]);
    __builtin_amdgcn_sched_barrier(0);
#pragma unroll
    for (int g = 0; g < 4; ++g) {
        o[g & 1] = __builtin_amdgcn_mfma_f32_32x32x16_bf16(va[g], __builtin_bit_cast(bf16x8, (g >> 1) ? pw1 : pw0), o[g & 1], 0, 0, 0);
#pragma unroll
        for (int e = 0; e < 4; ++e) { p1[4 * g + e] = __builtin_amdgcn_exp2f(__builtin_fmaf(p1[4 * g + e], LOG2E, nm2)); rs += p1[4 * g + e]; }
        __builtin_amdgcn_sched_barrier(0);
    }
    l += rs;
    pw0.x = cvtpk(p1[0], p1[1]); pw0.y = cvtpk(p1[2], p1[3]); pw0.z = cvtpk(p1[4], p1[5]); pw0.w = cvtpk(p1[6], p1[7]);
    pw1.x = cvtpk(p1[8], p1[9]); pw1.y = cvtpk(p1[10], p1[11]); pw1.z = cvtpk(p1[12], p1[13]); pw1.w = cvtpk(p1[14], p1[15]);
#pragma unroll
    for (int g = 0; g < 4; ++g) o[g & 1] = __builtin_amdgcn_mfma_f32_32x32x16_bf16(vb[g], __builtin_bit_cast(bf16x8, (g >> 1) ? pw1 : pw0), o[g & 1], 0, 0, 0);
}
__device__ __forceinline__ void attn_store(const f32x16* o, float l, bf16* orow, int hi) {
    l += __shfl_xor(l, 32);
    const float inv = 1.0f / l;
#pragma unroll
    for (int db = 0; db < 2; ++db)
#pragma unroll
        for (int g = 0; g < 4; ++g) { v2u w; w.x = cvtpk(o[db][4 * g] * inv, o[db][4 * g + 1] * inv); w.y = cvtpk(o[db][4 * g + 2] * inv, o[db][4 * g + 3] * inv);
            *(v2u*)(orow + 32 * db + 8 * g + 4 * hi) = w; }
}
__device__ __forceinline__ void stage_rows(int tid, int& rowA, int& rowB) { if (tid < 256) { rowA = tid >> 3; rowB = rowA + 32; } else { rowA = 2 * ((tid - 256) >> 3); rowB = rowA + 1; } }
__device__ __forceinline__ void stage_write(LAS unsigned char* buf, v4u ra, v4u rb, int tid) {
    const int c = tid & 7;
    if (tid < 256) { const int r = tid >> 3; *(LAS v4u*)(buf + r * KS_PITCH + c * 16) = ra; *(LAS v4u*)(buf + (r + 32) * KS_PITCH + c * 16) = rb; }
    else { const int p = (tid - 256) >> 3; LAS unsigned* vp = (LAS unsigned*)(buf + OFF_VT + (c * 8) * VT_PITCH + p * 4);
        vp[0 * 34] = (ra.x & 0xffffu) | (rb.x << 16); vp[1 * 34] = (ra.x >> 16) | (rb.x & 0xffff0000u);
        vp[2 * 34] = (ra.y & 0xffffu) | (rb.y << 16); vp[3 * 34] = (ra.y >> 16) | (rb.y & 0xffff0000u);
        vp[4 * 34] = (ra.z & 0xffffu) | (rb.z << 16); vp[5 * 34] = (ra.z >> 16) | (rb.z & 0xffff0000u);
        vp[6 * 34] = (ra.w & 0xffffu) | (rb.w << 16); vp[7 * 34] = (ra.w >> 16) | (rb.w & 0xffff0000u); }
}

__device__ __forceinline__ void swa_attn_phase(const bf16* QKV, const float* sinks, bf16* AO, LAS unsigned char* lds, int vcu, int G) {
    const int tid = opaque_tid();
    const int lane = tid & 63, wave = __builtin_amdgcn_readfirstlane(tid >> 6), r32 = lane & 31, hi = lane >> 5;
    int rowA, rowB; stage_rows(tid, rowA, rowB);
    constexpr int NCHUNK = BATCH * KVH * 16;
    for (int rep = 0; rep < PROBE_SWAREP; ++rep)
    for (int ch = vcu; ch < NCHUNK; ch += G) {
        const int b = ch >> 7, kvh = (ch >> 4) & 7, Q0 = (ch & 15) * 8;
        const int head = kvh * 4 + (wave >> 1);
        const float sink = sinks[head];
        const int colkv = (tid < 256 ? 2048 : 2560) + kvh * 64 + (tid & 7) * 8;
        const bf16* gA = QKV + ((size_t)b * SEQ + rowA) * N_SWA_IN + colkv;
        const bf16* gB = QKV + ((size_t)b * SEQ + rowB) * N_SWA_IN + colkv;
        const bf16* Qb = QKV + ((size_t)b * SEQ + 32 * (wave & 1) + r32) * N_SWA_IN + head * 64 + hi * 8;
        const int Tfirst = Q0 >= 2 ? Q0 - 2 : 0, Tlast = Q0 + 7;
        v4u ra = *(const v4u*)(gA + (size_t)Tfirst * 64 * N_SWA_IN), rb = *(const v4u*)(gB + (size_t)Tfirst * 64 * N_SWA_IN);
        v4u qn[4];
#pragma unroll
        for (int d0 = 0; d0 < 4; ++d0) qn[d0] = *(const v4u*)(Qb + (size_t)Q0 * 64 * N_SWA_IN + d0 * 16);
        __syncthreads();
        for (int T = Tfirst; T <= Tlast; ++T) {
            stage_write(lds + (T & 3) * ABUF, ra, rb, tid);
            if (T < Tlast) { ra = *(const v4u*)(gA + (size_t)(T + 1) * 64 * N_SWA_IN); rb = *(const v4u*)(gB + (size_t)(T + 1) * 64 * N_SWA_IN); }
            __syncthreads();
            if (T >= Q0) {
                bf16x8 qr[4];
#pragma unroll
                for (int d0 = 0; d0 < 4; ++d0) qr[d0] = scale_q(qn[d0]);
                if (T < Tlast) {
#pragma unroll
                    for (int d0 = 0; d0 < 4; ++d0) qn[d0] = *(const v4u*)(Qb + (size_t)(T + 1) * 64 * N_SWA_IN + d0 * 16);
                }
                const int qpos = T * 64 + 32 * (wave & 1) + r32;
                f32x16 o[2];
#pragma unroll
                for (int r = 0; r < 16; ++r) { o[0][r] = 0.f; o[1][r] = 0.f; }
                float m = sink, l = hi ? 0.f : 1.f;
                attn_tile<0, false>(lds + (T & 3) * ABUF, qr, o, m, l, qpos, T * 64, r32, hi, true);
                if (T >= 1) attn_tile<0, false>(lds + ((T - 1) & 3) * ABUF, qr, o, m, l, qpos, (T - 1) * 64, r32, hi, false);
                if (T >= 2) attn_tile<0, true>(lds + ((T - 2) & 3) * ABUF, qr, o, m, l, qpos, (T - 2) * 64, r32, hi, false);
                attn_store(o, l, AO + ((size_t)b * SEQ + qpos) * DM + head * 64, hi);
            }
        }
    }
    __syncthreads();
}

template <int VAR>
__device__ __forceinline__ void fox_attn_phase(const bf16* QKV, const float* CUM, const float* KPART, bf16* AO, int* JST, unsigned* Q, LAS unsigned char* lds, int vcu, int G) {
    const int tid = opaque_tid();
    const int lane = tid & 63, wave = __builtin_amdgcn_readfirstlane(tid >> 6), r32 = lane & 31, hi = lane >> 5;
    int rowA, rowB; stage_rows(tid, rowA, rowB);
    volatile LAS unsigned* flags = (volatile LAS unsigned*)(lds + 2 * ABUF);
    constexpr int NUNIT = BATCH * NH * (SEQ / 256);
    volatile LAS int* uq = (volatile LAS int*)(lds + 2 * ABUF + 64);
    if (tid == 0) uq[0] = (int)__hip_atomic_fetch_add(Q, 1u, __ATOMIC_RELAXED, __HIP_MEMORY_SCOPE_AGENT);
    __syncthreads();
    int ui = uq[0];
    while (ui < NUNIT) {
        int unext = 0;
        if (tid == 0) unext = (int)__hip_atomic_fetch_add(Q, 1u, __ATOMIC_RELAXED, __HIP_MEMORY_SCOPE_AGENT);
        const int bh = (ui & 255) >> 2, qb = 31 - (4 * (ui >> 8) + (ui & 3));
        const int b = bh >> 5, h = bh & 31;
        const int q0 = qb * 256, R = q0 + wave * 32, qpos = R + r32;
        const size_t tok = (size_t)b * SEQ + qpos;
        const bf16* Qp = QKV + tok * N_FOX_MAIN + h * 64 + hi * 8;
        bf16x8 qr[4]; float qn2 = 0.f;
#pragma unroll
        for (int d0 = 0; d0 < 4; ++d0) { const v4u w = *(const v4u*)(Qp + d0 * 16); const unsigned ww[4] = {w.x, w.y, w.z, w.w};
#pragma unroll
            for (int e = 0; e < 4; ++e) { const float x0 = bf2f((unsigned short)(ww[e] & 0xffffu)), x1 = bf2f((unsigned short)(ww[e] >> 16)); qn2 += x0 * x0 + x1 * x1; }
            qr[d0] = scale_q(w); }
        qn2 += __shfl_xor(qn2, 32);
        const float4 kp = *(const float4*)(KPART + bh * 4);
        const float kmax = fmaxf(fmaxf(kp.x, kp.y), fmaxf(kp.z, kp.w)) * 1.001f;
        const float qk_bound = 0.125f * sqrtf(qn2) * 1.001f * kmax;
        const float* suf = CUM + (size_t)bh * SEQ; const float* tot = CUM + (size_t)BATCH * NH * SEQ + bh * 128;
        float Tstage = 0.f, Tv = 0.f;
        f32x16 o[2];
#pragma unroll
        for (int r = 0; r < 16; ++r) { o[0][r] = 0.f; o[1][r] = 0.f; }
        float m = -INFINITY, l = 0.f;
        const int jmax = 4 * qb + 3, jw = (R + 31) >> 6;
        int jstop = -1;
        const int colkv = (tid < 256 ? 2048 : 4096) + h * 64 + (tid & 7) * 8;
        const bf16* gA = QKV + ((size_t)b * SEQ + rowA) * N_FOX_MAIN + colkv;
        const bf16* gB = QKV + ((size_t)b * SEQ + rowB) * N_FOX_MAIN + colkv;
        const bool brole = (tid >= 256 && tid < 320);
        v4u ra = *(const v4u*)(gA + (size_t)jmax * 64 * N_FOX_MAIN), rb = *(const v4u*)(gB + (size_t)jmax * 64 * N_FOX_MAIN);
        float breg = brole ? suf[jmax * 64 + (tid - 256)] : 0.f;
        float totreg = tot[jmax];
        __syncthreads();
        if (tid < 3) flags[tid] = 0u;
        stage_write(lds + (jmax & 1) * ABUF, ra, rb, tid);
        if (brole) ((LAS float*)(lds + (jmax & 1) * ABUF + OFF_BS))[tid - 256] = breg;
        Tstage = totreg;
        if (jmax > 0) { ra = *(const v4u*)(gA + (size_t)(jmax - 1) * 64 * N_FOX_MAIN); rb = *(const v4u*)(gB + (size_t)(jmax - 1) * 64 * N_FOX_MAIN); if (brole) breg = suf[(jmax - 1) * 64 + (tid - 256)]; totreg = tot[jmax - 1]; }
        for (int j = jmax; j >= 0; --j) {
            bool need = true;
            if (VAR == 0) { if (j <= jw) { const float U = qk_bound + Tv; need = !__all(((U - m) * LOG2E) < -130.0f); } }
            else need = j > jstop;
            if (j != jmax && need && lane == 0) flags[j % 3] = 1u;
            __syncthreads();
            if (j != jmax && flags[j % 3] == 0u) { jstop = j; break; }
            if (VAR == 1) __builtin_amdgcn_s_sleep(127);
            if (tid == 0) flags[(j + 1) % 3] = 0u;
            if (j > 0) {
                stage_write(lds + ((j - 1) & 1) * ABUF, ra, rb, tid);
                if (brole) ((LAS float*)(lds + ((j - 1) & 1) * ABUF + OFF_BS))[tid - 256] = Tstage + breg;
                Tv = Tstage; Tstage += totreg;
                if (j > 1) { ra = *(const v4u*)(gA + (size_t)(j - 2) * 64 * N_FOX_MAIN); rb = *(const v4u*)(gB + (size_t)(j - 2) * 64 * N_FOX_MAIN); if (brole) breg = suf[(j - 2) * 64 + (tid - 256)]; totreg = tot[j - 2]; }
            }
            if (VAR == 0 && j <= jw && need) {
                attn_tile<1, false>(lds + (j & 1) * ABUF, qr, o, m, l, qpos, j * 64, r32, hi, j * 64 + 63 > R);
            }
        }
        attn_store(o, l, AO + tok * DM + h * 64, hi);
        if (tid == 0) uq[0] = unext;
        __syncthreads();
        ui = uq[0];
    }
    __syncthreads();
}

__device__ __forceinline__ void fox_cumsum_phase(const float* GATE, const float* bfv, float* CUM, const bf16* QKV, float* KPART, LAS unsigned char* lds) {
    const int tid = opaque_tid();
    const int lane = tid & 63, wave = tid >> 6;
    LAS double* wtot = (LAS double*)lds;
    { LAS float* wmax = (LAS float*)(lds + 256);
      for (int u = blockIdx.x; u < BATCH * NH * 4; u += gridDim.x) {
        const int bh = u >> 2, qtr = u & 3, b = bh >> 5, h = bh & 31;
        float mx = 0.f;
        for (int i = 0; i < 4; ++i) {
            const bf16* kp = QKV + ((size_t)b * SEQ + qtr * 2048 + i * 512 + tid) * N_FOX_MAIN + 2048 + h * 64;
            float ss = 0.f;
#pragma unroll
            for (int c = 0; c < 8; ++c) { const v4u w = *(const v4u*)(kp + c * 8); const unsigned ww[4] = {w.x, w.y, w.z, w.w};
#pragma unroll
                for (int e = 0; e < 4; ++e) { const float x0 = bf2f((unsigned short)(ww[e] & 0xffffu)), x1 = bf2f((unsigned short)(ww[e] >> 16)); ss += x0 * x0 + x1 * x1; } }
            mx = fmaxf(mx, ss);
        }
#pragma unroll
        for (int o = 1; o < 64; o <<= 1) mx = fmaxf(mx, __shfl_xor(mx, o));
        __syncthreads();
        if (lane == 0) wmax[wave] = mx;
        __syncthreads();
        if (tid == 0) { float t = wmax[0]; for (int w = 1; w < NWAVES; ++w) t = fmaxf(t, wmax[w]); KPART[u] = sqrtf(t); }
      }
      __syncthreads(); }
    for (int it = blockIdx.x; it < BATCH * (SEQ / 64); it += gridDim.x) {
        const int b = it >> 7, tile = it & 127;
        const f32x4 z4 = *(const f32x4*)(GATE + ((size_t)b * SEQ + tile * 64 + lane) * 32 + wave * 4);
#pragma unroll
        for (int e = 0; e < 4; ++e) {
            const int h = wave * 4 + e; const float z = z4[e] + bfv[h];
            const float lf = fminf(z, 0.f) - log1pf(expf(-fabsf(z)));
            float v = lf;
            v += row_shl<1>(v); v += row_shl<2>(v); v += row_shl<4>(v); v += row_shl<8>(v);
            const int vi = __float_as_int(v);
            const float r0 = __int_as_float(__builtin_amdgcn_readlane(vi, 0)), r1 = __int_as_float(__builtin_amdgcn_readlane(vi, 16)), r2 = __int_as_float(__builtin_amdgcn_readlane(vi, 32)), r3 = __int_as_float(__builtin_amdgcn_readlane(vi, 48));
            const int row = lane >> 4;
            const float later = row == 0 ? (r1 + r2) + r3 : row == 1 ? r2 + r3 : row == 2 ? r3 : 0.f;
            CUM[((size_t)(b * 32 + h)) * SEQ + tile * 64 + lane] = (v - lf) + later;
            if (lane == 0) CUM[(size_t)BATCH * NH * SEQ + (b * 32 + h) * 128 + tile] = (r0 + r1) + (r2 + r3);
        }
    }
    __syncthreads();
}

typedef __attribute__((address_space(1))) unsigned gu32;
#define XB_TMO      128
#define XB_XCNT(j)  (256  + 64 * (j))
#define XB_XSUB(j)  (1280 + 64 * (j))
#define XB_XGEN(j)  (2304 + 64 * (j))
#define XB_TOP      3328
#define XB_TOPGEN   3392
#define XCD_BAR_WORDS 3456
#define XB_SPIN_CAP (1u << 18)

__device__ __forceinline__ unsigned xb_ld(unsigned* p)              { return __hip_atomic_load(p, __ATOMIC_RELAXED, __HIP_MEMORY_SCOPE_AGENT); }
__device__ __forceinline__ unsigned xb_add(unsigned* p, unsigned v) { return __hip_atomic_fetch_add(p, v, __ATOMIC_RELAXED, __HIP_MEMORY_SCOPE_AGENT); }
__device__ __forceinline__ unsigned xb_xcc_id() { return (unsigned)__builtin_amdgcn_s_getreg((3 << 11) | 20) & 0xFu; }
#define XB_SPIN(cond, bar) do { unsigned _sp = 0; while (cond) { __builtin_amdgcn_s_sleep(1); \
    if ((++_sp & 255u) == 0u) { if (xb_ld(&(bar)[XB_TMO])) break; if (_sp > XB_SPIN_CAP) { atomicAdd(&(bar)[XB_TMO], 1u); break; } } } } while (0)

struct XcdBarrier {
    unsigned* bar; unsigned x;
    volatile LAS unsigned* st;
};

__device__ __forceinline__ XcdBarrier xcd_barrier_post(unsigned* bar, volatile LAS unsigned* st) {
    XcdBarrier b; b.bar = bar; b.x = xb_xcc_id(); b.st = st;
    if (threadIdx.x == 0) (void)xb_add(&bar[XB_XCNT(b.x)], 1u);
    return b;
}
__device__ __forceinline__ void xcd_barrier_complete(unsigned* bar, unsigned x, unsigned& nloc, unsigned& nx) {
    const unsigned G = gridDim.x * gridDim.y * gridDim.z;
    unsigned sum, cnt, mine, sp = 0u;
    for (;;) {
        sum = 0u; cnt = 0u; mine = 0u;
#pragma unroll
        for (unsigned j = 0; j < 16; ++j) { const unsigned c = xb_ld(&bar[XB_XCNT(j)]); sum += c; cnt += (c > 0u) ? 1u : 0u; mine = (j == x) ? c : mine; }
        if (sum == G) break;
        __builtin_amdgcn_s_sleep(1);
        if ((++sp & 255u) == 0u) { if (xb_ld(&bar[XB_TMO])) break; if (sp > XB_SPIN_CAP) { atomicAdd(&bar[XB_TMO], 1u); break; } }
    }
    nloc = mine > 0u ? mine : 1u; nx = cnt > 0u ? cnt : 1u;
}

__device__ __forceinline__ void xcd_barrier(const XcdBarrier& b) {
    asm volatile("s_waitcnt vmcnt(0)" ::: "memory");
    __syncthreads();
    if (threadIdx.x == 0) {
        unsigned* bar = b.bar;
        __builtin_amdgcn_s_waitcnt(0);
        unsigned nloc = b.st[0], nx = b.st[1];
        if (nloc == 0u) { xcd_barrier_complete(bar, b.x, nloc, nx); b.st[0] = nloc; b.st[1] = nx; }
        const unsigned old = xb_add(&bar[XB_XSUB(b.x)], 1u);
        const unsigned gen = old / nloc;
        if (old + 1u == (gen + 1u) * nloc) {
            __builtin_amdgcn_fence(__ATOMIC_RELEASE, "agent");
            asm volatile("s_waitcnt vmcnt(0)" ::: "memory");
            const unsigned og = xb_add(&bar[XB_TOP], 1u);
            const unsigned tg = og / nx;
            if (og + 1u == (tg + 1u) * nx) xb_add(&bar[XB_TOPGEN], 1u);
            else XB_SPIN(xb_ld(&bar[XB_TOPGEN]) == tg, bar);
            __builtin_amdgcn_fence(__ATOMIC_ACQUIRE, "agent");
            xb_add(&bar[XB_XGEN(b.x)], 1u);
            asm volatile("s_waitcnt vmcnt(0)" ::: "memory");
        } else {
            XB_SPIN(xb_ld(&bar[XB_XGEN(b.x)]) == gen, bar);
            __builtin_amdgcn_fence(__ATOMIC_ACQUIRE, "agent");
            asm volatile("s_waitcnt vmcnt(0)" ::: "memory");
        }
    }
    __syncthreads();
}

struct Args { const float* x; const int* pos; const float* gains; const float* swa_w_in; const float* swa_sinks; const float* swa_w_out; const float* fox_w_in; const float* fox_b_f; const float* fox_w_out;
              const float* w_gu; const float* w_dn; float* out; unsigned char* ws; };

__global__ void __launch_bounds__(NWAVES * 64, 2) mega_fwd(Args a) {
    extern __shared__ __attribute__((aligned(16))) unsigned char lds_raw[];
    cg::grid_group grid = cg::this_grid();
    LAS unsigned char* lds = (LAS unsigned char*)lds_raw;
    const int G = gridDim.x, bx = blockIdx.x;
    const int vcu = (G % 8 == 0) ? (bx % 8) * (G / 8) + bx / 8 : bx;
    const int NGW = G * NWAVES;
    unsigned char* ws = a.ws;
    bf16* WSI = (bf16*)(ws + WS_WSI); bf16* WSO = (bf16*)(ws + WS_WSO); bf16* WFI = (bf16*)(ws + WS_WFI); bf16* WFO = (bf16*)(ws + WS_WFO); bf16* WGU = (bf16*)(ws + WS_WGU); bf16* WDN = (bf16*)(ws + WS_WDN);
    bf16* XN = (bf16*)(ws + WS_XN); bf16* QKV = (bf16*)(ws + WS_QKV); bf16* HB = (bf16*)(ws + WS_HB); bf16* AO = (bf16*)(ws + WS_AO);
    float* Y = (float*)(ws + WS_Y); float* ROPE = (float*)(ws + WS_ROPE); float* GATE = (float*)(ws + WS_GATE); float* CUM = (float*)(ws + WS_CUM);

    volatile LAS unsigned* MISC = (volatile LAS unsigned*)(lds + MISC_OFF);
    if (threadIdx.x < 32) MISC[threadIdx.x] = 0u;
    if (bx == 0) { for (int u = threadIdx.x; u < 4096 + 128; u += NWAVES * 64) ((unsigned*)(ws + WS_CTL))[u] = 0u; }
    for (int prorep = 0; prorep < PROBE_PROREP; ++prorep) {
        const int tid = opaque_tid(), lane = tid & 63, wave = __builtin_amdgcn_readfirstlane(tid >> 6), gw = vcu * NWAVES + wave;
        LAS float* scr = (LAS float*)(lds + wave * 16384);
        transpose_family<false>(a.swa_w_in, 2, DM, N_SWA_IN, WSI, (size_t)N_SWA_IN * DM, scr, gw, NGW, lane);
        transpose_family<false>(a.swa_w_out, 2, DM, DM, WSO, (size_t)DM * DM, scr, gw, NGW, lane);
        transpose_family<false>(a.fox_w_in, 2, DM, N_FOX_IN, WFI, (size_t)N_FOX_PAD * DM, scr, gw, NGW, lane);
        transpose_family<false>(a.fox_w_out, 2, DM, DM, WFO, (size_t)DM * DM, scr, gw, NGW, lane);
        transpose_family<true>(a.w_gu, 4, DM, N_GU, WGU, (size_t)N_GU * DM, scr, gw, NGW, lane);
        transpose_family<false>(a.w_dn, 4, DFF, DM, WDN, (size_t)DM * DFF, scr, gw, NGW, lane);
        for (int it = gw * 64 + lane; it < 2 * 57344; it += NGW * 64) { const int mi = it / 57344, r = it % 57344;
            *(v4u*)(WFI + (size_t)mi * N_FOX_PAD * DM + (size_t)N_FOX_IN * DM + (size_t)r * 8) = (v4u){0u, 0u, 0u, 0u}; }
        for (int it = gw * 64 + lane; it < M * 8; it += NGW * 64) { const int tk = it >> 3, i = it & 7;
            const float inv = powf(500000.0f, -(float)i * 0.125f); const float ang = (float)a.pos[tk] * inv;
            const double rev = (double)ang * 0.15915494309189535; const double fr = rev - rint(rev); const float rad = (float)(fr * 6.283185307179586);
            ROPE[it] = cosf(rad); ROPE[(size_t)M * 8 + it] = sinf(rad); }
        prenorm_rows(a.x, a.gains, XN, vcu, NGW);
    }
    grid.sync();
    const XcdBarrier bar = xcd_barrier_post((unsigned*)(ws + WS_CTL), MISC + 8);

    for (int it = 0; it < 8 * DEPTH + PROBE_DUP; ++it) {
        const int ph = (PROBE_DUP && it > PROBE_PH) ? it - 1 : it;
        const int layer = ph >> 3, st = ph & 7, fox = layer & 1, j = layer >> 1;
        if (st == 1 && !fox) continue;
        const __attribute__((address_space(4))) Args* ka = (const __attribute__((address_space(4))) Args*)__builtin_amdgcn_kernarg_segment_ptr();
        asm volatile("" : "+s"(ka));
        unsigned char* ws = ka->ws;
        const int nrep = (st == PROBE_ST && (layer & 1) == PROBE_LAYER) ? 2 : 1;
        for (int rep = 0; rep < nrep; ++rep) {
        if (st == 0 || st == 3 || st == 5 || st == 6) {
            size_t aoff, boff, ooff; int N, K, mode, ldc, ntm = 1 << 30;
            if (st == 0) { aoff = WS_XN; ooff = WS_QKV; K = DM; mode = 0;
                if (!fox) { boff = WS_WSI + (size_t)j * N_SWA_IN * DM * 2; N = N_SWA_IN; ldc = N_SWA_IN; }
                else { boff = WS_WFI + (size_t)j * N_FOX_PAD * DM * 2; N = N_FOX_PAD; ldc = N_FOX_MAIN; ntm = N_FOX_MAIN / 256; } }
            else if (st == 3) { aoff = WS_AO; boff = (fox ? WS_WFO : WS_WSO) + (size_t)j * DM * DM * 2; ooff = WS_Y; N = DM; K = DM; mode = 1; ldc = DM; }
            else if (st == 5) { aoff = WS_XN; boff = WS_WGU + (size_t)layer * N_GU * DM * 2; ooff = WS_HB; N = N_GU; K = DM; mode = 2; ldc = DFF; }
            else { aoff = WS_HB; boff = WS_WDN + (size_t)layer * DM * DFF * 2; ooff = WS_Y; N = DM; K = DFF; mode = 1; ldc = DM; }
            pg8::Gemm gm{(const bf16*)(ws + aoff), (const bf16*)(ws + boff), M, N, K}; pg8::StaticOrder S; S.init(M, N, G, bx);
            pg8::EpiAny E{mode, true, ws + ooff, ldc, ntm, (float*)(ws + ((st == 0 && !fox) ? WS_ROPE : WS_GATE))};
            pg8::gemm_phase<pg8::EpiAny, pg8::StaticOrder, PG8_ALIGN, PG8_SP2>(lds, gm, S, E);
        } else if (st == 1) {
            fox_cumsum_phase((const float*)(ws + WS_GATE), ka->fox_b_f + j * NH, (float*)(ws + WS_CUM), (const bf16*)(ws + WS_QKV), (float*)(ws + WS_KPART), lds);
        } else if (st == 2) {
            if (!fox) swa_attn_phase((const bf16*)(ws + WS_QKV), ka->swa_sinks + j * NH, (bf16*)(ws + WS_AO), lds, vcu, G);
            else { fox_attn_phase<0>((const bf16*)(ws + WS_QKV), (const float*)(ws + WS_CUM), (const float*)(ws + WS_KPART), (bf16*)(ws + WS_AO), (int*)(ws + WS_KPART + 65536), (unsigned*)(ws + WS_CTL) + 4096 + 64 * j, lds, vcu, G);
                   }
        } else {
            const float* g = ka->gains + (size_t)layer * 4 * DM + (st == 4 ? DM : 3 * DM);
            float* outp = ka->out; const float* Xsrc = (ph == 4) ? ka->x : outp;
            post_rows(Xsrc, (const bf16*)(ws + WS_Y), g, g + DM, outp, (bf16*)(ws + WS_XN), ph != 8 * DEPTH - 1, vcu, NGW);
        }
        }
        if (it != 8 * DEPTH + PROBE_DUP - 1) { for (int r = 0; r < PROBE_NSYNC; ++r) xcd_barrier(bar); }
    }
}

extern "C" void kernel_launch(void* const* d_in, const int* in_sizes, int n_in, void* d_out, int out_size, void* d_ws, size_t ws_size, hipStream_t stream) {
    static int grid = 0;
    if (grid == 0) {
        if (n_in != 11 || in_sizes[0] != M * DM || out_size != M * DM || ws_size < WS_END) { fprintf(stderr, "kernel_launch: unexpected shapes (n_in %d, in0 %d, out %d, ws %zu); nothing launched\n", n_in, n_in > 0 ? in_sizes[0] : -1, out_size, ws_size); grid = -1; return; }
        int dev = 0, cus = 0, per_cu = 0;
        if (hipGetDevice(&dev) != hipSuccess || hipDeviceGetAttribute(&cus, hipDeviceAttributeMultiprocessorCount, dev) != hipSuccess) { grid = -1; return; }
        if (hipFuncSetAttribute((const void*)mega_fwd, hipFuncAttributeMaxDynamicSharedMemorySize, LDS_BYTES) != hipSuccess) { fprintf(stderr, "kernel_launch: hipFuncSetAttribute failed\n"); grid = -1; return; }
        if (hipOccupancyMaxActiveBlocksPerMultiprocessor(&per_cu, (const void*)mega_fwd, NWAVES * 64, LDS_BYTES) != hipSuccess || per_cu < 1) { fprintf(stderr, "kernel_launch: occupancy query says %d\n", per_cu); per_cu = 1; }
        (void)hipGetLastError();
        grid = cus * per_cu;
    }
    if (grid < 0) return;
    Args a{};
    a.x = (const float*)d_in[0]; a.pos = (const int*)d_in[1]; a.gains = (const float*)d_in[2]; a.swa_w_in = (const float*)d_in[3]; a.swa_sinks = (const float*)d_in[4]; a.swa_w_out = (const float*)d_in[5];
    a.fox_w_in = (const float*)d_in[6]; a.fox_b_f = (const float*)d_in[7]; a.fox_w_out = (const float*)d_in[8]; a.w_gu = (const float*)d_in[9]; a.w_dn = (const float*)d_in[10];
    a.out = (float*)d_out; a.ws = (unsigned char*)d_ws;
    void* args[] = {&a};
    const hipError_t e = hipLaunchCooperativeKernel((const void*)mega_fwd, dim3(grid), dim3(NWAVES * 64), args, LDS_BYTES, stream);
    if (e != hipSuccess) fprintf(stderr, "kernel_launch: cooperative launch failed: %s (grid %d)\n", hipGetErrorString(e), grid);
}
```

```cpp
#include <hip/hip_runtime.h>
#include <hip/hip_cooperative_groups.h>
#include <cstdio>
#include <cstdint>
#include <cmath>
namespace cg = cooperative_groups;
namespace pg8 {
#define PG8_LAS __attribute__((address_space(3)))
typedef unsigned short bf16_t;
typedef short bf16x8 __attribute__((ext_vector_type(8)));
typedef float f32x4 __attribute__((ext_vector_type(4)));
typedef unsigned u32x4 __attribute__((ext_vector_type(4)));
constexpr int BM = 256, BK = 64, HALF = 128, HTB = HALF * BK * 2  , STAGE_BYTES = 8 * HTB, NXCD = 8, WGM = 8;

__host__ __device__ __forceinline__ int lds_byte(int r, int c) { const int st = (r >> 4) * 2 + (c >> 5), rr = r & 15, cc = c & 31, ob = rr * 64 + cc * 2; return st * 1024 + (ob ^ (((ob >> 9) & 1) << 5)); }
__host__ __device__ __forceinline__ void stage_rc(int b, int& R, int& C) { const int st = b / 1024, sb = b % 1024, swz = sb ^ (((sb >> 9) & 1) << 5); R = (st >> 1) * 16 + swz / 64; C = (st & 1) * 32 + (swz % 64) / 2; }
__host__ __device__ __forceinline__ int perm32(int rho) { const int n = rho >> 4, i = rho & 15; return 8 * (i >> 2) + 4 * n + (i & 3); }

struct Unit { int pm, pn; };
struct Gemm { const bf16_t* A; const bf16_t* Bt; int M, N, K; };

struct StaticOrder {
    int nM, nN, nwg, G, c;
    __host__ __device__ void init(int M, int N, int G_, int c_) { nM = M / BM; nN = N / BM; nwg = nM * nN; G = G_; c = c_; }
    __host__ __device__ bool next(int i, Unit& u) const {
        const long L = (long)i * G + c; if (L >= nwg) return false;
        int wgid = (int)L; { const int q = nwg / NXCD, r = nwg % NXCD, xcd = wgid % NXCD, off = wgid / NXCD; wgid = (xcd < r ? xcd * (q + 1) : r * (q + 1) + (xcd - r) * q) + off; }
        const int nig = WGM * nN, gid = wgid / nig, fm = gid * WGM, gsz = (nM - fm) < WGM ? (nM - fm) : WGM;
        u.pm = fm + ((wgid % nig) % gsz); u.pn = (wgid % nig) / gsz; return true;
    }
    __device__ __forceinline__ void a_ready(const Unit&) const {}
    __device__ __forceinline__ void done(const Unit&) const {}
};

__device__ __forceinline__ unsigned cvt_pk_bf16(float lo, float hi) { unsigned r; asm volatile("v_cvt_pk_bf16_f32 %0, %1, %2" : "=v"(r) : "v"(lo), "v"(hi)); return r; }
typedef float f32x2 __attribute__((ext_vector_type(2)));
struct EpiQKV {
    static constexpr bool PERM = true, AFTER_DRAIN = false;
    bf16_t* O; int ldc; int ntile_main; float* G;
    __device__ __forceinline__ void plain(const f32x4 (&acc)[2][2][4][2], const Unit& u, int wr, int wc, int fr, int fq) const {
        const int row0 = u.pm * BM + wr * 64 + fr, col0 = u.pn * BM + wc * 32 + 8 * fq;
#pragma unroll
        for (int ai = 0; ai < 2; ++ai)
#pragma unroll
            for (int m = 0; m < 4; ++m) { bf16_t* rowp = O + (size_t)(row0 + ai * HALF + m * 16) * ldc + col0;
#pragma unroll
                for (int bj = 0; bj < 2; ++bj) { const f32x4 v0 = acc[ai][bj][m][0], v1 = acc[ai][bj][m][1];
                    u32x4 w; w.x = cvt_pk_bf16(v0[0], v0[1]); w.y = cvt_pk_bf16(v0[2], v0[3]); w.z = cvt_pk_bf16(v1[0], v1[1]); w.w = cvt_pk_bf16(v1[2], v1[3]);
                    *(u32x4*)(rowp + bj * HALF) = w; } }
    }
    __device__ __forceinline__ void operator()(const f32x4 (&acc)[2][2][4][2], const Unit& u, int wr, int wc, int fr, int fq) const {
        const int row0 = u.pm * BM + wr * 64 + fr;
        if (u.pn < ntile_main) {
            const int col0 = u.pn * BM + wc * 32 + 8 * fq;
            const bool rot = (ntile_main > 4096) && (u.pn < 10) && ((wc & 1) == 0);
            const float sg = fq == 0 ? -1.f : 1.f;
#pragma unroll
            for (int ai = 0; ai < 2; ++ai)
#pragma unroll
                for (int m = 0; m < 4; ++m) { const int row = row0 + ai * HALF + m * 16; bf16_t* rowp = O + (size_t)row * ldc + col0;
                    f32x4 c0 = {1.f, 1.f, 1.f, 1.f}, c1 = c0, s0 = {0.f, 0.f, 0.f, 0.f}, s1 = s0;
                    if (rot) { const float* cp = G + (size_t)row * 8; c0 = *(const f32x4*)cp; c1 = *(const f32x4*)(cp + 4); s0 = *(const f32x4*)(cp + 131072); s1 = *(const f32x4*)(cp + 131072 + 4); }
#pragma unroll
                    for (int bj = 0; bj < 2; ++bj) { f32x4 v0 = acc[ai][bj][m][0], v1 = acc[ai][bj][m][1];
                        if (rot) { f32x4 q0, q1;
#pragma unroll
                            for (int e = 0; e < 4; ++e) { q0[e] = __shfl_xor(v0[e], 16); q1[e] = __shfl_xor(v1[e], 16); }
                            if (fq < 2) { v0 = v0 * c0 + sg * q0 * s0; v1 = v1 * c1 + sg * q1 * s1; } }
                        u32x4 w; w.x = cvt_pk_bf16(v0[0], v0[1]); w.y = cvt_pk_bf16(v0[2], v0[3]); w.z = cvt_pk_bf16(v1[0], v1[1]); w.w = cvt_pk_bf16(v1[2], v1[3]);
                        *(u32x4*)(rowp + bj * HALF) = w; } }
        } else if (wc == 0) {
#pragma unroll
            for (int ai = 0; ai < 2; ++ai)
#pragma unroll
                for (int m = 0; m < 4; ++m) { float* gp = G + (size_t)(row0 + ai * HALF + m * 16) * 32 + 8 * fq;
                    *(f32x4*)gp = acc[ai][0][m][0]; *(f32x4*)(gp + 4) = acc[ai][0][m][1]; }
        }
    }
};
struct EpiF32 {
    static constexpr bool PERM = false, AFTER_DRAIN = false;
    float* Y; int ldc;
    __device__ __forceinline__ void operator()(const f32x4 (&acc)[2][2][4][2], const Unit& u, int wr, int wc, int fr, int fq) const {
        const int row0 = u.pm * BM + wr * 64 + fr, col0 = u.pn * BM + wc * 32 + 4 * fq;
#pragma unroll
        for (int ai = 0; ai < 2; ++ai)
#pragma unroll
            for (int m = 0; m < 4; ++m) { float* rowp = Y + (size_t)(row0 + ai * HALF + m * 16) * ldc + col0;
#pragma unroll
                for (int bj = 0; bj < 2; ++bj)
#pragma unroll
                    for (int n = 0; n < 2; ++n) *(f32x4*)(rowp + bj * HALF + n * 16) = acc[ai][bj][m][n]; }
    }
};
struct EpiSwiGLU {
    static constexpr bool PERM = true, AFTER_DRAIN = false;
    bf16_t* Hout; int ldc;
    static __device__ __forceinline__ float sw(float g, float up) { return g * __builtin_amdgcn_rcpf(1.0f + __builtin_amdgcn_exp2f(-1.4426950408889634f * g)) * up; }
    __device__ __forceinline__ void operator()(const f32x4 (&acc)[2][2][4][2], const Unit& u, int wr, int wc, int fr, int fq) const {
        const int row0 = u.pm * BM + wr * 64 + fr, col0 = u.pn * HALF + wc * 32 + 8 * fq;
#pragma unroll
        for (int ai = 0; ai < 2; ++ai)
#pragma unroll
            for (int m = 0; m < 4; ++m) { bf16_t* rowp = Hout + (size_t)(row0 + ai * HALF + m * 16) * ldc + col0;
                const f32x4 g0 = acc[ai][0][m][0], g1 = acc[ai][0][m][1], u0 = acc[ai][1][m][0], u1 = acc[ai][1][m][1];
                u32x4 w; w.x = cvt_pk_bf16(sw(g0[0], u0[0]), sw(g0[1], u0[1])); w.y = cvt_pk_bf16(sw(g0[2], u0[2]), sw(g0[3], u0[3]));
                w.z = cvt_pk_bf16(sw(g1[0], u1[0]), sw(g1[1], u1[1])); w.w = cvt_pk_bf16(sw(g1[2], u1[2]), sw(g1[3], u1[3]));
                *(u32x4*)rowp = w; }
    }
};

struct EpiAny {
    static constexpr bool AFTER_DRAIN = false;
    int mode; bool PERM; unsigned char* O; int ldc; int ntile_main; float* G;
    __device__ __forceinline__ void operator()(const f32x4 (&acc)[2][2][4][2], const Unit& u, int wr, int wc, int fr, int fq) const {
        if (mode == 0) { EpiQKV e{(bf16_t*)O, ldc, ntile_main, G}; e(acc, u, wr, wc, fr, fq); }
        else if (mode == 1) { EpiQKV e{(bf16_t*)O, ldc, 1 << 20, nullptr}; e.plain(acc, u, wr, wc, fr, fq); }
        else { EpiSwiGLU e{(bf16_t*)O, ldc}; e(acc, u, wr, wc, fr, fq); }
    }
};

template <class Epi, class Sched, bool ALIGN_EPI = false, bool SP2 = false>
__device__ __forceinline__ void gemm_phase(PG8_LAS unsigned char* lds, const Gemm g, const Sched& S, const Epi& E) {
    const int tid = threadIdx.x, wid = __builtin_amdgcn_readfirstlane(tid >> 6), lane = tid & 63, wr = wid >> 2, wc = wid & 3, fr = lane & 15, fq = lane >> 4;
    const int K = g.K, nt = K / BK;
    unsigned voffA[2], voffB[2];
#pragma unroll
    for (int i = 0; i < 2; ++i) { int R, C; stage_rc(tid * 16 + i * 8192, R, C); const int Rb = E.PERM ? ((R & ~31) + perm32(R & 31)) : R;
        voffA[i] = (unsigned)(R * K + C) * 2u; voffB[i] = (unsigned)(Rb * K + C) * 2u; }
    const size_t kstep = (size_t)(BK * 2);
    const size_t hstep = (size_t)HALF * K * 2;
    const size_t tstep = 2 * hstep;
    const unsigned ldsw = (unsigned)wid * 1024u;
    const int aoff = lds_byte(wr * 64 + fr, fq * 8), boff = lds_byte(wc * 32 + fr, fq * 8);
#define PG8_SA(b, h) (((b) * 2 + (h)) * HTB)
#define PG8_SB(b, h) ((4 + (b) * 2 + (h)) * HTB)
#define PG8_STAGE(bufoff, gbase, voff) do { _Pragma("unroll") for (int _i = 0; _i < 2; ++_i) \
        __builtin_amdgcn_global_load_lds((const unsigned*)((const char*)(gbase) + (voff)[_i]), (PG8_LAS unsigned*)(lds + (bufoff) + ldsw + _i * 8192), 16, 0, 0); } while (0)
#define PG8_LDA(dst, b, h) do { _Pragma("unroll") for (int m = 0; m < 4; ++m) _Pragma("unroll") for (int k = 0; k < 2; ++k) dst[m][k] = *(const PG8_LAS bf16x8*)(lds + PG8_SA(b, h) + aoff + m * 2048 + k * 1024); } while (0)
#define PG8_LDB(dst, b, h) do { _Pragma("unroll") for (int n = 0; n < 2; ++n) _Pragma("unroll") for (int k = 0; k < 2; ++k) dst[n][k] = *(const PG8_LAS bf16x8*)(lds + PG8_SB(b, h) + boff + n * 2048 + k * 1024); } while (0)
#define PG8_MMA(ai, bj, At, Bt) do { __builtin_amdgcn_s_setprio(1); _Pragma("unroll") for (int m = 0; m < 4; ++m) _Pragma("unroll") for (int n = 0; n < 2; ++n) _Pragma("unroll") for (int k = 0; k < 2; ++k) \
        acc[ai][bj][m][n] = __builtin_amdgcn_mfma_f32_16x16x32_bf16(Bt[n][k], At[m][k], acc[ai][bj][m][n], 0, 0, 0); __builtin_amdgcn_s_setprio(0); } while (0)
#define PG8_WAIT_V(n) asm volatile("s_waitcnt vmcnt(" #n ")" ::: "memory")
#define PG8_WAIT_L(n) asm volatile("s_waitcnt lgkmcnt(" #n ")" ::: "memory")
#define PG8_BAR __builtin_amdgcn_s_barrier()
#define PG8_SCHED __builtin_amdgcn_sched_barrier(0)
    Unit cur, nxt; int ui = 0;
    if (!S.next(0, cur)) return;
    f32x4 acc[2][2][4][2];
#pragma unroll
    for (int a = 0; a < 2; ++a)
#pragma unroll
        for (int b = 0; b < 2; ++b)
#pragma unroll
            for (int m = 0; m < 4; ++m)
#pragma unroll
                for (int n = 0; n < 2; ++n) acc[a][b][m][n] = (f32x4){0.f, 0.f, 0.f, 0.f};
    bf16x8 At[4][2], B0[2][2], B1[2][2];
    const char* cA = (const char*)g.A + (size_t)cur.pm * tstep; const char* cB = (const char*)g.Bt + (size_t)cur.pn * tstep;
    S.a_ready(cur);
    if constexpr (SP2) {
        PG8_STAGE(PG8_SB(0, 0), cB, voffB); PG8_STAGE(PG8_SB(0, 1), cB + hstep, voffB); PG8_STAGE(PG8_SA(0, 0), cA, voffA); PG8_STAGE(PG8_SA(0, 1), cA + hstep, voffA);
        if (wr == 1) PG8_BAR;
        PG8_WAIT_V(2); PG8_BAR;
        PG8_STAGE(PG8_SB(1, 0), cB + kstep, voffB); PG8_STAGE(PG8_SA(1, 0), cA + kstep, voffA); PG8_STAGE(PG8_SB(1, 1), cB + hstep + kstep, voffB);
        PG8_WAIT_V(6); PG8_BAR;
    } else {
        PG8_STAGE(PG8_SB(0, 0), cB, voffB); PG8_STAGE(PG8_SA(0, 0), cA, voffA); PG8_STAGE(PG8_SB(0, 1), cB + hstep, voffB); PG8_STAGE(PG8_SA(0, 1), cA + hstep, voffA);
        if (wr == 1) PG8_BAR;
        PG8_WAIT_V(4); PG8_BAR;
        PG8_STAGE(PG8_SB(1, 0), cB + kstep, voffB); PG8_STAGE(PG8_SA(1, 0), cA + kstep, voffA); PG8_STAGE(PG8_SB(1, 1), cB + hstep + kstep, voffB);
        PG8_WAIT_V(6); PG8_BAR;
    }
    for (;;) {
        const bool has_next = S.next(ui + 1, nxt);
        const char* nA = has_next ? (const char*)g.A + (size_t)nxt.pm * tstep : cA; const char* nB = has_next ? (const char*)g.Bt + (size_t)nxt.pn * tstep : cB;
        for (int t = 0; t < nt; t += 2) {
            const bool last = (t == nt - 2);
            const char* a1 = cA + (size_t)(t + 1) * kstep;
            const char* a2 = last ? nA : cA + (size_t)(t + 2) * kstep; const char* b2 = last ? nB : cB + (size_t)(t + 2) * kstep;
            const char* a3 = a2 + kstep; const char* b3 = b2 + kstep;
            if (last && has_next) S.a_ready(nxt);
            if constexpr (SP2) {
            PG8_LDB(B0, 0, 0); PG8_LDB(B1, 0, 1); PG8_SCHED; PG8_LDA(At, 0, 0); PG8_STAGE(PG8_SA(1, 1), a1 + hstep, voffA);
            PG8_WAIT_V(8); PG8_WAIT_L(0); PG8_BAR; PG8_MMA(0, 0, At, B0); PG8_MMA(0, 1, At, B1); PG8_BAR; PG8_SCHED;
            PG8_LDA(At, 0, 1); PG8_STAGE(PG8_SB(0, 0), b2, voffB); PG8_STAGE(PG8_SB(0, 1), b2 + hstep, voffB); PG8_STAGE(PG8_SA(0, 0), a2, voffA);
            PG8_WAIT_V(8); PG8_WAIT_L(0); PG8_BAR; PG8_MMA(1, 0, At, B0); PG8_MMA(1, 1, At, B1); PG8_BAR; PG8_SCHED;
            PG8_LDB(B0, 1, 0); PG8_LDB(B1, 1, 1); PG8_SCHED; PG8_LDA(At, 1, 0); PG8_STAGE(PG8_SA(0, 1), a2 + hstep, voffA);
            PG8_WAIT_V(8); PG8_WAIT_L(0); PG8_BAR; PG8_MMA(0, 0, At, B0); PG8_MMA(0, 1, At, B1); PG8_BAR; PG8_SCHED;
            PG8_LDA(At, 1, 1); PG8_STAGE(PG8_SB(1, 0), b3, voffB); PG8_STAGE(PG8_SB(1, 1), b3 + hstep, voffB); PG8_STAGE(PG8_SA(1, 0), a3, voffA);
            PG8_WAIT_V(8); PG8_WAIT_L(0); PG8_BAR; PG8_MMA(1, 0, At, B0); PG8_MMA(1, 1, At, B1); PG8_BAR; PG8_SCHED;
            } else {
            PG8_LDB(B0, 0, 0); PG8_SCHED; PG8_LDA(At, 0, 0); PG8_STAGE(PG8_SA(1, 1), a1 + hstep, voffA);
            PG8_WAIT_L(8); PG8_BAR; PG8_WAIT_L(0); PG8_MMA(0, 0, At, B0); PG8_BAR; PG8_SCHED;
            PG8_LDB(B1, 0, 1); PG8_STAGE(PG8_SB(0, 0), b2, voffB);
            PG8_BAR; PG8_WAIT_L(0); PG8_MMA(0, 1, At, B1); PG8_BAR;
            PG8_LDA(At, 0, 1); PG8_STAGE(PG8_SA(0, 0), a2, voffA);
            PG8_BAR; PG8_WAIT_L(0); PG8_MMA(1, 0, At, B0); PG8_BAR; PG8_SCHED;
            PG8_STAGE(PG8_SB(0, 1), b2 + hstep, voffB);
            PG8_WAIT_V(6); PG8_BAR; PG8_MMA(1, 1, At, B1); PG8_BAR;
            PG8_LDB(B0, 1, 0); PG8_SCHED; PG8_LDA(At, 1, 0); PG8_STAGE(PG8_SA(0, 1), a2 + hstep, voffA);
            PG8_WAIT_L(8); PG8_BAR; PG8_WAIT_L(0); PG8_MMA(0, 0, At, B0); PG8_BAR; PG8_SCHED;
            PG8_LDB(B1, 1, 1); PG8_STAGE(PG8_SB(1, 0), b3, voffB);
            PG8_BAR; PG8_WAIT_L(0); PG8_MMA(0, 1, At, B1); PG8_BAR;
            PG8_LDA(At, 1, 1); PG8_STAGE(PG8_SA(1, 0), a3, voffA);
            PG8_BAR; PG8_WAIT_L(0); PG8_MMA(1, 0, At, B0); PG8_BAR; PG8_SCHED;
            PG8_STAGE(PG8_SB(1, 1), b3 + hstep, voffB);
            PG8_WAIT_V(6); PG8_BAR; PG8_MMA(1, 1, At, B1); PG8_BAR;
            }
        }
        if constexpr (ALIGN_EPI) { if (wr == 0) PG8_BAR; }
        if constexpr (!Epi::AFTER_DRAIN) { E(acc, cur, wr, wc, fr, fq); S.done(cur); }
        if (!has_next) break;
#pragma unroll
        for (int a = 0; a < 2; ++a)
#pragma unroll
            for (int b = 0; b < 2; ++b)
#pragma unroll
                for (int m = 0; m < 4; ++m)
#pragma unroll
                    for (int n = 0; n < 2; ++n) acc[a][b][m][n] = (f32x4){0.f, 0.f, 0.f, 0.f};
        cur = nxt; cA = nA; cB = nB; ++ui;
        if constexpr (ALIGN_EPI) { if (wr == 1) PG8_BAR; }
    }
    PG8_WAIT_V(0);
    if constexpr (!ALIGN_EPI) { if (wr == 0) PG8_BAR; }
    PG8_BAR;
    if constexpr (Epi::AFTER_DRAIN) { E.fused(acc, cur, wr, wc, fr, fq, lds, wid, lane); S.done(cur); }
#undef PG8_SA
#undef PG8_SB
#undef PG8_STAGE
#undef PG8_LDA
#undef PG8_LDB
#undef PG8_MMA
#undef PG8_WAIT_V
#undef PG8_WAIT_L
#undef PG8_BAR
#undef PG8_SCHED
}
}
#define PG8_ALIGN true
#ifndef PROBE_ST
#define PROBE_ST -1
#define PROBE_LAYER 1
#define PROBE_NSYNC 1
#define PROBE_DUP 0
#define PROBE_PH 8
#define PROBE_FOXREP 1
#define PROBE_FOXVAR 0
#define PROBE_PROREP 1
#define PROBE_SWAREP 1
#endif
#define PG8_SP2 true
constexpr int NWAVES = 8;
constexpr int BATCH = 2, SEQ = 8192, DM = 2048, M = BATCH * SEQ, NH = 32, HD = 64, KVH = 8, DFF = 5632, DEPTH = 4;
constexpr int N_SWA_IN = 3072, N_FOX_IN = 6176, N_FOX_PAD = 6400, N_FOX_MAIN = 6144, N_GU = 2 * DFF;
constexpr float RMS_EPS = 1e-6f, LOG2E = 1.4426950408889634f, C2 = 0.125f * 1.4426950408889634f;
constexpr size_t MiB = 1u << 20; constexpr int RING_BYTES_C = 131072;
constexpr size_t WS_CTL = 0;
constexpr int MISC_OFF = RING_BYTES_C + 320;
constexpr size_t WS_ROPE = 1 * MiB, WS_GATE = 2 * MiB, WS_CUM = 4 * MiB, WS_KPART = 6 * MiB;
constexpr size_t WS_WSI = 8 * MiB, WS_WSO = 32 * MiB, WS_WFI = 48 * MiB, WS_WFO = 98 * MiB, WS_WGU = 114 * MiB, WS_WDN = 290 * MiB;
constexpr size_t WS_XN = 378 * MiB, WS_QKV = 442 * MiB, WS_HB = WS_QKV, WS_AO = 634 * MiB, WS_Y = 698 * MiB, WS_END = 826 * MiB;
static_assert(WS_WSI + 2ull * N_SWA_IN * DM * 2 <= WS_WSO && WS_WSO + 2ull * DM * DM * 2 <= WS_WFI && WS_WFI + 2ull * N_FOX_PAD * DM * 2 <= WS_WFO && WS_WFO + 2ull * DM * DM * 2 <= WS_WGU
              && WS_WGU + 4ull * N_GU * DM * 2 <= WS_WDN && WS_WDN + 4ull * DM * DFF * 2 <= WS_XN && WS_XN + (size_t)M * DM * 2 <= WS_QKV && WS_QKV + (size_t)M * N_FOX_MAIN * 2 <= WS_AO
              && WS_HB + (size_t)M * DFF * 2 <= WS_AO && WS_AO + (size_t)M * DM * 2 <= WS_Y && WS_Y + (size_t)M * DM * 2 <= WS_END, "d_ws map");
constexpr int RING_BYTES = 131072, LDS_BYTES = 147456;

#define LAS __attribute__((address_space(3)))
typedef unsigned short bf16;
typedef unsigned v4u __attribute__((ext_vector_type(4)));
typedef unsigned v2u __attribute__((ext_vector_type(2)));
typedef float f32x4 __attribute__((ext_vector_type(4)));
typedef float f32x16 __attribute__((ext_vector_type(16)));
typedef short bf16x8 __attribute__((ext_vector_type(8)));
typedef short s16x4 __attribute__((ext_vector_type(4)));
#define LDS_WAIT() asm volatile("s_waitcnt lgkmcnt(0)" ::: "memory")
__device__ __forceinline__ unsigned f2bf(float f) { unsigned u = __builtin_bit_cast(unsigned, f); return (u + 0x7fffu + ((u >> 16) & 1u)) >> 16; }
__device__ __forceinline__ unsigned pk2(float lo, float hi) { return f2bf(lo) | (f2bf(hi) << 16); }
typedef float f32x2_t __attribute__((ext_vector_type(2))); typedef __bf16 bf16x2_t __attribute__((ext_vector_type(2)));
__device__ __forceinline__ unsigned cvtpk(float lo, float hi) { f32x2_t v = {lo, hi}; bf16x2_t b = __builtin_convertvector(v, bf16x2_t); return __builtin_bit_cast(unsigned, b); }
__device__ __forceinline__ float bf2f(unsigned short b) { return __builtin_bit_cast(float, (unsigned)b << 16); }
__device__ __forceinline__ float wave_sum(float v) {
#pragma unroll
    for (int o = 1; o < 64; o <<= 1) v += __shfl_xor(v, o);
    return v;
}

__device__ __forceinline__ int opaque_tid() { int t = threadIdx.x; asm volatile("" : "+v"(t)); return t; }
__device__ __forceinline__ void transpose_item(const float* W, int K, int N, bf16* WT, int k0, int n0, int drow0, LAS float* scr, int lane) {
#pragma unroll 8
    for (int i = 0; i < 32; ++i) { const int kk = 2 * i + (lane >> 5); scr[kk * 33 + (lane & 31)] = __builtin_nontemporal_load(W + (size_t)(k0 + kk) * N + n0 + (lane & 31)); }
    LDS_WAIT(); asm volatile("" ::: "memory");
    const int c = lane & 7;
#pragma unroll
    for (int j = 0; j < 4; ++j) { const int n = (lane >> 3) + 8 * j; const LAS float* s = scr + (8 * c) * 33 + n;
        v4u o; o.x = pk2(s[0 * 33], s[1 * 33]); o.y = pk2(s[2 * 33], s[3 * 33]); o.z = pk2(s[4 * 33], s[5 * 33]); o.w = pk2(s[6 * 33], s[7 * 33]);
        __builtin_nontemporal_store(o, (v4u*)(WT + (size_t)(drow0 + n) * K + k0 + 8 * c)); }
    LDS_WAIT(); asm volatile("" ::: "memory");
}
template <bool GU>
__device__ __forceinline__ void transpose_family(const float* W, int nmat, int K, int N, bf16* WT, size_t dstride, LAS float* scr, int gw, int NGW, int lane) {
    const int nblk = N / 32, per = (K / 64) * nblk, total = nmat * per;
    for (int it = gw; it < total; it += NGW) {
        const int mi = it / per, r = it % per, kb = r / nblk, nb = r % nblk, n0 = nb * 32;
        int drow0 = n0;
        if (GU) { const int j = n0 < DFF ? n0 : n0 - DFF; drow0 = (j >> 7) * 256 + (n0 < DFF ? 0 : 128) + (j & 127); }
        transpose_item(W + (size_t)mi * K * N, K, N, WT + (size_t)mi * dstride, kb * 64, n0, drow0, scr, lane);
    }
}
__device__ __forceinline__ void prenorm_rows(const float* X, const float* g, bf16* XN, int vcu, int NGW) {
    const int tid = opaque_tid(), lane = tid & 63, gw = vcu * NWAVES + __builtin_amdgcn_readfirstlane(tid >> 6);
    for (int m = gw; m < M; m += NGW) {
        const f32x4* xr = (const f32x4*)(X + (size_t)m * DM) + lane;
        f32x4 x[8]; float ss = 0.f;
#pragma unroll
        for (int j = 0; j < 8; ++j) { x[j] = __builtin_nontemporal_load(xr + 64 * j); ss += (x[j].x * x[j].x + x[j].y * x[j].y) + (x[j].z * x[j].z + x[j].w * x[j].w); }
        const float r = 1.0f / sqrtf(wave_sum(ss) * (1.0f / DM) + RMS_EPS);
        v2u* o8 = (v2u*)(XN + (size_t)m * DM) + lane;
#pragma unroll
        for (int j = 0; j < 8; ++j) { const f32x4 gg = ((const f32x4*)g)[lane + 64 * j]; v2u w; w.x = pk2(x[j].x * r * gg.x, x[j].y * r * gg.y); w.y = pk2(x[j].z * r * gg.z, x[j].w * r * gg.w); o8[64 * j] = w; }
    }
}
__device__ __forceinline__ void post_rows(const float* Xsrc, const bf16* Y, const float* g1, const float* g2, float* Xdst, bf16* XN, bool do_next, int vcu, int NGW) {
    const int tid = opaque_tid(), lane = tid & 63, gw = vcu * NWAVES + __builtin_amdgcn_readfirstlane(tid >> 6);
    v2u yw[8], ywn[8]; f32x4 x[8], xn[8], gg1[8], gg2[8];
#pragma unroll
    for (int j = 0; j < 8; ++j) { gg1[j] = ((const f32x4*)g1)[lane + 64 * j]; gg2[j] = do_next ? ((const f32x4*)g2)[lane + 64 * j] : gg1[j]; }
    if (gw < M) {
        const v2u* yr = (const v2u*)(Y + (size_t)gw * DM) + lane; const f32x4* xr = (const f32x4*)(Xsrc + (size_t)gw * DM) + lane;
#pragma unroll
        for (int j = 0; j < 8; ++j) { ywn[j] = __builtin_nontemporal_load(yr + 64 * j); xn[j] = __builtin_nontemporal_load(xr + 64 * j); }
    }
    for (int m = gw; m < M; m += NGW) {
#pragma unroll
        for (int j = 0; j < 8; ++j) { yw[j] = ywn[j]; x[j] = xn[j]; }
        if (m + NGW < M) {
            const v2u* yr = (const v2u*)(Y + (size_t)(m + NGW) * DM) + lane; const f32x4* xr = (const f32x4*)(Xsrc + (size_t)(m + NGW) * DM) + lane;
#pragma unroll
            for (int j = 0; j < 8; ++j) { ywn[j] = __builtin_nontemporal_load(yr + 64 * j); xn[j] = __builtin_nontemporal_load(xr + 64 * j); }
        }
        f32x4* xo = (f32x4*)(Xdst + (size_t)m * DM) + lane;
        f32x4 y[8]; float ss = 0.f;
#pragma unroll
        for (int j = 0; j < 8; ++j) { const v2u w = yw[j]; y[j] = (f32x4){bf2f((unsigned short)(w.x & 0xffffu)), bf2f((unsigned short)(w.x >> 16)), bf2f((unsigned short)(w.y & 0xffffu)), bf2f((unsigned short)(w.y >> 16))};
            ss += (y[j].x * y[j].x + y[j].y * y[j].y) + (y[j].z * y[j].z + y[j].w * y[j].w); }
        const float r1 = 1.0f / sqrtf(wave_sum(ss) * (1.0f / DM) + RMS_EPS);
        float s2 = 0.f;
#pragma unroll
        for (int j = 0; j < 8; ++j) { const f32x4 gg = gg1[j]; x[j] = x[j] + y[j] * r1 * gg; s2 += (x[j].x * x[j].x + x[j].y * x[j].y) + (x[j].z * x[j].z + x[j].w * x[j].w); __builtin_nontemporal_store(x[j], xo + 64 * j); }
        if (do_next) {
            const float r2 = 1.0f / sqrtf(wave_sum(s2) * (1.0f / DM) + RMS_EPS);
            v2u* o8 = (v2u*)(XN + (size_t)m * DM) + lane;
#pragma unroll
            for (int j = 0; j < 8; ++j) { const f32x4 gg = gg2[j]; v2u w; w.x = cvtpk(x[j].x * r2 * gg.x, x[j].y * r2 * gg.y); w.y = cvtpk(x[j].z * r2 * gg.z, x[j].w * r2 * gg.w); o8[64 * j] = w; }
        }
    }
}

constexpr int KS_PITCH = 144, VT_PITCH = 136, OFF_VT = 9216, OFF_BS = 17920, ABUF = 18432;
__device__ __forceinline__ float max3f(float a, float b, float c) { float r; asm("v_max3_f32 %0, %1, %2, %3" : "=v"(r) : "v"(a), "v"(b), "v"(c)); return r; }
__device__ __forceinline__ float max2f(float a, float b) { float r; asm("v_max_f32_e32 %0, %1, %2" : "=v"(r) : "v"(a), "v"(b)); return r; }
__device__ __forceinline__ float xhalf_max(float v) { auto rr = __builtin_amdgcn_permlane32_swap(__float_as_uint(v), __float_as_uint(v), false, false); return max2f(__uint_as_float(rr[0]), __uint_as_float(rr[1])); }
__device__ __forceinline__ bf16x8 scale_q(v4u w) {
    const unsigned ww[4] = {w.x, w.y, w.z, w.w}; unsigned r[4];
#pragma unroll
    for (int i = 0; i < 4; ++i) r[i] = cvtpk(bf2f((unsigned short)(ww[i] & 0xffffu)) * 0.125f, bf2f((unsigned short)(ww[i] >> 16)) * 0.125f);
    v4u o; o.x = r[0]; o.y = r[1]; o.z = r[2]; o.w = r[3]; return __builtin_bit_cast(bf16x8, o);
}
template <int MODE, bool WINDOW>
__device__ __forceinline__ void attn_tile(const LAS unsigned char* buf, const bf16x8* qr, f32x16* o, float& m, float& l, int qpos, int kbase, int r32, int hi, const bool CAUSAL) {
    const LAS unsigned char* Ks = buf; const LAS unsigned char* Vt = buf + OFF_VT; const LAS float* Bs = (const LAS float*)(buf + OFF_BS);
    f32x16 p0, p1;
    if (MODE == 1) {
#pragma unroll
        for (int g = 0; g < 4; ++g) { const f32x4 b0 = *(const LAS f32x4*)(Bs + 8 * g + 4 * hi), b1 = *(const LAS f32x4*)(Bs + 32 + 8 * g + 4 * hi);
#pragma unroll
            for (int e = 0; e < 4; ++e) { p0[4 * g + e] = b0[e]; p1[4 * g + e] = b1[e]; } }
    } else {
#pragma unroll
        for (int r = 0; r < 16; ++r) { p0[r] = 0.f; p1[r] = 0.f; }
    }
#pragma unroll
    for (int d0 = 0; d0 < 4; ++d0) {
        const bf16x8 a0 = *(const LAS bf16x8*)(Ks + r32 * KS_PITCH + d0 * 32 + hi * 16);
        const bf16x8 a1 = *(const LAS bf16x8*)(Ks + (32 + r32) * KS_PITCH + d0 * 32 + hi * 16);
        p0 = __builtin_amdgcn_mfma_f32_32x32x16_bf16(a0, qr[d0], p0, 0, 0, 0);
        p1 = __builtin_amdgcn_mfma_f32_32x32x16_bf16(a1, qr[d0], p1, 0, 0, 0);
    }
    if (CAUSAL || WINDOW) {
#pragma unroll
        for (int r = 0; r < 16; ++r) {
            const int kv0 = kbase + (r & 3) + 8 * (r >> 2) + 4 * hi, kv1 = kv0 + 32;
            bool v0 = true, v1 = true;
            if (CAUSAL) { v0 = kv0 <= qpos; v1 = kv1 <= qpos; }
            if (WINDOW) { v0 = v0 && (qpos - kv0 < 128); v1 = v1 && (qpos - kv1 < 128); }
            p0[r] = v0 ? p0[r] : -INFINITY; p1[r] = v1 ? p1[r] : -INFINITY;
        }
    }
    asm volatile("s_nop 15\n\ts_nop 7" : "+v"(p0), "+v"(p1));
    float mxa = max3f(p0[0], p1[0], p0[1]), mxb = max3f(p1[1], p0[2], p1[2]);
#pragma unroll
    for (int r = 3; r < 15; r += 2) { mxa = max3f(mxa, p0[r], p1[r]); mxb = max3f(mxb, p0[r + 1], p1[r + 1]); }
    mxa = max3f(mxa, p0[15], p1[15]);
    const float mx = xhalf_max(max2f(mxa, mxb));
    bf16x8 va[4], vb[4];
#pragma unroll
    for (int g = 0; g < 4; ++g) {
        const LAS unsigned char* vp = Vt + (32 * (g & 1) + r32) * VT_PITCH + (16 * (g >> 1) + 4 * hi) * 2;
        const s16x4 lo = *(const LAS s16x4*)vp, h4 = *(const LAS s16x4*)(vp + 16), lo2 = *(const LAS s16x4*)(vp + 64), h42 = *(const LAS s16x4*)(vp + 80);
        va[g] = (bf16x8){lo[0], lo[1], lo[2], lo[3], h4[0], h4[1], h4[2], h4[3]};
        vb[g] = (bf16x8){lo2[0], lo2[1], lo2[2], lo2[3], h42[0], h42[1], h42[2], h42[3]};
    }
    const float mn = max2f(m, mx);
    if (__any(mn > m)) {
        const float alpha = __builtin_amdgcn_exp2f((m - mn) * LOG2E);
        l *= alpha;
#pragma unroll
        for (int r = 0; r < 16; ++r) { o[0][r] *= alpha; o[1][r] *= alpha; }
    }
    m = mn;
    const float nm2 = -mn * LOG2E;
    float rs = 0.f;
#pragma unroll
    for (int r = 0; r < 16; ++r) { p0[r] = __builtin_amdgcn_exp2f(__builtin_fmaf(p0[r], LOG2E, nm2)); rs += p0[r]; }
    v4u pw0, pw1;
    pw0.x = cvtpk(p0[0], p0[1]); pw0.y = cvtpk(p0[2], p0[3]); pw0.z = cvtpk(p0[4], p0[5]); pw0.w = cvtpk(p0[6], p0[7]);
    pw1.x = cvtpk(p0[8], p0[9]); pw1.y = cvtpk(p0[10], p0[11]); pw1.z = cvtpk(p0[12], p0[13]); pw1.w = cvtpk(p0[14], p0[15]);
    __builtin_amdgcn_sched_barrier(0);
#pragma unroll
    for (int g = 0; g < 4; ++g) {
        o[g & 1] = __builtin_amdgcn_mfma_f32_32x32x16_bf16(va[g], __builtin_bit_cast(bf16x8, (g >> 1) ? pw1 : pw0), o[g & 1], 0, 0, 0);
#pragma unroll
        for (int e = 0; e < 4; ++e) { p1[4 * g + e] = __builtin_amdgcn_exp2f(__builtin_fmaf(p1[4 * g + e], LOG2E, nm2)); rs += p1[4 * g + e]; }
        __builtin_amdgcn_sched_barrier(0);
    }
    l += rs;
    pw0.x = cvtpk(p1[0], p1[1]); pw0.y = cvtpk(p1[2], p1[3]); pw0.z = cvtpk(p1[4], p1[5]); pw0.w = cvtpk(p1[6], p1[7]);
    pw1.x = cvtpk(p1[8], p1[9]); pw1.y = cvtpk(p1[10], p1[11]); pw1.z = cvtpk(p1[12], p1[13]); pw1.w = cvtpk(p1[14], p1[15]);
#pragma unroll
    for (int g = 0; g < 4; ++g) o[g & 1] = __builtin_amdgcn_mfma_f32_32x32x16_bf16(vb[g], __builtin_bit_cast(bf16x8, (g >> 1) ? pw1 : pw0), o[g & 1], 0, 0, 0);
}
__device__ __forceinline__ void attn_store(const f32x16* o, float l, bf16* orow, int hi) {
    l += __shfl_xor(l, 32);
    const float inv = 1.0f / l;
#pragma unroll
    for (int db = 0; db < 2; ++db)
#pragma unroll
        for (int g = 0; g < 4; ++g) { v2u w; w.x = cvtpk(o[db][4 * g] * inv, o[db][4 * g + 1] * inv); w.y = cvtpk(o[db][4 * g + 2] * inv, o[db][4 * g + 3] * inv);
            *(v2u*)(orow + 32 * db + 8 * g + 4 * hi) = w; }
}
__device__ __forceinline__ void stage_rows(int tid, int& rowA, int& rowB) { if (tid < 256) { rowA = tid >> 3; rowB = rowA + 32; } else { rowA = 2 * ((tid - 256) >> 3); rowB = rowA + 1; } }
__device__ __forceinline__ void stage_write(LAS unsigned char* buf, v4u ra, v4u rb, int tid) {
    const int c = tid & 7;
    if (tid < 256) { const int r = tid >> 3; *(LAS v4u*)(buf + r * KS_PITCH + c * 16) = ra; *(LAS v4u*)(buf + (r + 32) * KS_PITCH + c * 16) = rb; }
    else { const int p = (tid - 256) >> 3; LAS unsigned* vp = (LAS unsigned*)(buf + OFF_VT + (c * 8) * VT_PITCH + p * 4);
        vp[0 * 34] = (ra.x & 0xffffu) | (rb.x << 16); vp[1 * 34] = (ra.x >> 16) | (rb.x & 0xffff0000u);
        vp[2 * 34] = (ra.y & 0xffffu) | (rb.y << 16); vp[3 * 34] = (ra.y >> 16) | (rb.y & 0xffff0000u);
        vp[4 * 34] = (ra.z & 0xffffu) | (rb.z << 16); vp[5 * 34] = (ra.z >> 16) | (rb.z & 0xffff0000u);
        vp[6 * 34] = (ra.w & 0xffffu) | (rb.w << 16); vp[7 * 34] = (ra.w >> 16) | (rb.w & 0xffff0000u); }
}

__device__ __forceinline__ void swa_attn_phase(const bf16* QKV, const float* sinks, bf16* AO, LAS unsigned char* lds, int vcu, int G) {
    const int tid = opaque_tid();
    const int lane = tid & 63, wave = __builtin_amdgcn_readfirstlane(tid >> 6), r32 = lane & 31, hi = lane >> 5;
    int rowA, rowB; stage_rows(tid, rowA, rowB);
    constexpr int NCHUNK = BATCH * KVH * 16;
    for (int rep = 0; rep < PROBE_SWAREP; ++rep)
    for (int ch = vcu; ch < NCHUNK; ch += G) {
        const int b = ch >> 7, kvh = (ch >> 4) & 7, Q0 = (ch & 15) * 8;
        const int head = kvh * 4 + (wave >> 1);
        const float sink = sinks[head];
        const int colkv = (tid < 256 ? 2048 : 2560) + kvh * 64 + (tid & 7) * 8;
        const bf16* gA = QKV + ((size_t)b * SEQ + rowA) * N_SWA_IN + colkv;
        const bf16* gB = QKV + ((size_t)b * SEQ + rowB) * N_SWA_IN + colkv;
        const bf16* Qb = QKV + ((size_t)b * SEQ + 32 * (wave & 1) + r32) * N_SWA_IN + head * 64 + hi * 8;
        const int Tfirst = Q0 >= 2 ? Q0 - 2 : 0, Tlast = Q0 + 7;
        v4u ra = *(const v4u*)(gA + (size_t)Tfirst * 64 * N_SWA_IN), rb = *(const v4u*)(gB + (size_t)Tfirst * 64 * N_SWA_IN);
        v4u qn[4];
#pragma unroll
        for (int d0 = 0; d0 < 4; ++d0) qn[d0] = *(const v4u*)(Qb + (size_t)Q0 * 64 * N_SWA_IN + d0 * 16);
        __syncthreads();
        for (int T = Tfirst; T <= Tlast; ++T) {
            stage_write(lds + (T & 3) * ABUF, ra, rb, tid);
            if (T < Tlast) { ra = *(const v4u*)(gA + (size_t)(T + 1) * 64 * N_SWA_IN); rb = *(const v4u*)(gB + (size_t)(T + 1) * 64 * N_SWA_IN); }
            __syncthreads();
            if (T >= Q0) {
                bf16x8 qr[4];
#pragma unroll
                for (int d0 = 0; d0 < 4; ++d0) qr[d0] = scale_q(qn[d0]);
                if (T < Tlast) {
#pragma unroll
                    for (int d0 = 0; d0 < 4; ++d0) qn[d0] = *(const v4u*)(Qb + (size_t)(T + 1) * 64 * N_SWA_IN + d0 * 16);
                }
                const int qpos = T * 64 + 32 * (wave & 1) + r32;
                f32x16 o[2];
#pragma unroll
                for (int r = 0; r < 16; ++r) { o[0][r] = 0.f; o[1][r] = 0.f; }
                float m = sink, l = hi ? 0.f : 1.f;
                attn_tile<0, false>(lds + (T & 3) * ABUF, qr, o, m, l, qpos, T * 64, r32, hi, true);
                if (T >= 1) attn_tile<0, false>(lds + ((T - 1) & 3) * ABUF, qr, o, m, l, qpos, (T - 1) * 64, r32, hi, false);
                if (T >= 2) attn_tile<0, true>(lds + ((T - 2) & 3) * ABUF, qr, o, m, l, qpos, (T - 2) * 64, r32, hi, false);
                attn_store(o, l, AO + ((size_t)b * SEQ + qpos) * DM + head * 64, hi);
            }
        }
    }
    __syncthreads();
}

template <int VAR>
__device__ __forceinline__ void fox_attn_phase(const bf16* QKV, const float* CUM, const float* KPART, bf16* AO, int* JST, unsigned* Q, LAS unsigned char* lds, int vcu, int G) {
    const int tid = opaque_tid();
    const int lane = tid & 63, wave = __builtin_amdgcn_readfirstlane(tid >> 6), r32 = lane & 31, hi = lane >> 5;
    int rowA, rowB; stage_rows(tid, rowA, rowB);
    volatile LAS unsigned* flags = (volatile LAS unsigned*)(lds + 2 * ABUF);
    constexpr int NUNIT = BATCH * NH * (SEQ / 256);
    volatile LAS int* uq = (volatile LAS int*)(lds + 2 * ABUF + 64);
    if (tid == 0) uq[0] = (int)__hip_atomic_fetch_add(Q, 1u, __ATOMIC_RELAXED, __HIP_MEMORY_SCOPE_AGENT);
    __syncthreads();
    int ui = uq[0];
    while (ui < NUNIT) {
        int unext = 0;
        if (tid == 0) unext = (int)__hip_atomic_fetch_add(Q, 1u, __ATOMIC_RELAXED, __HIP_MEMORY_SCOPE_AGENT);
        const int bh = (ui & 255) >> 2, qb = 31 - (4 * (ui >> 8) + (ui & 3));
        const int b = bh >> 5, h = bh & 31;
        const int q0 = qb * 256, R = q0 + wave * 32, qpos = R + r32;
        const size_t tok = (size_t)b * SEQ + qpos;
        const bf16* Qp = QKV + tok * N_FOX_MAIN + h * 64 + hi * 8;
        bf16x8 qr[4]; float qn2 = 0.f;
#pragma unroll
        for (int d0 = 0; d0 < 4; ++d0) { const v4u w = *(const v4u*)(Qp + d0 * 16); const unsigned ww[4] = {w.x, w.y, w.z, w.w};
#pragma unroll
            for (int e = 0; e < 4; ++e) { const float x0 = bf2f((unsigned short)(ww[e] & 0xffffu)), x1 = bf2f((unsigned short)(ww[e] >> 16)); qn2 += x0 * x0 + x1 * x1; }
            qr[d0] = scale_q(w); }
        qn2 += __shfl_xor(qn2, 32);
        const float4 kp = *(const float4*)(KPART + bh * 4);
        const float kmax = fmaxf(fmaxf(kp.x, kp.y), fmaxf(kp.z, kp.w)) * 1.001f;
        const float qk_bound = 0.125f * sqrtf(qn2) * 1.001f * kmax;
        const float* cum = CUM + (size_t)bh * SEQ;
        const float cref = cum[q0];
        f32x16 o[2];
#pragma unroll
        for (int r = 0; r < 16; ++r) { o[0][r] = 0.f; o[1][r] = 0.f; }
        float m = -INFINITY, l = 0.f;
        const int jmax = 4 * qb + 3, jw = (R + 31) >> 6;
        int jstop = -1;
        const int colkv = (tid < 256 ? 2048 : 4096) + h * 64 + (tid & 7) * 8;
        const bf16* gA = QKV + ((size_t)b * SEQ + rowA) * N_FOX_MAIN + colkv;
        const bf16* gB = QKV + ((size_t)b * SEQ + rowB) * N_FOX_MAIN + colkv;
        const bool brole = (tid >= 256 && tid < 320);
        v4u ra = *(const v4u*)(gA + (size_t)jmax * 64 * N_FOX_MAIN), rb = *(const v4u*)(gB + (size_t)jmax * 64 * N_FOX_MAIN);
        float breg = brole ? cum[jmax * 64 + (tid - 256)] : 0.f;
        float cend = cum[jmax * 64 + 63], cend_n = cend;
        __syncthreads();
        if (tid < 3) flags[tid] = 0u;
        stage_write(lds + (jmax & 1) * ABUF, ra, rb, tid);
        if (brole) ((LAS float*)(lds + (jmax & 1) * ABUF + OFF_BS))[tid - 256] = cref - breg;
        if (jmax > 0) { ra = *(const v4u*)(gA + (size_t)(jmax - 1) * 64 * N_FOX_MAIN); rb = *(const v4u*)(gB + (size_t)(jmax - 1) * 64 * N_FOX_MAIN); if (brole) breg = cum[(jmax - 1) * 64 + (tid - 256)]; cend_n = cum[(jmax - 1) * 64 + 63]; }
        for (int j = jmax; j >= 0; --j) {
            bool need = true;
            if (VAR == 0) { if (j <= jw) { const float U = qk_bound + (cref - cend); need = !__all(((U - m) * LOG2E) < -130.0f); } }
            else need = j > jstop;
            if (j != jmax && need && lane == 0) flags[j % 3] = 1u;
            __syncthreads();
            if (j != jmax && flags[j % 3] == 0u) { jstop = j; break; }
            if (VAR == 1) __builtin_amdgcn_s_sleep(127);
            if (tid == 0) flags[(j + 1) % 3] = 0u;
            if (j > 0) {
                stage_write(lds + ((j - 1) & 1) * ABUF, ra, rb, tid);
                if (brole) ((LAS float*)(lds + ((j - 1) & 1) * ABUF + OFF_BS))[tid - 256] = cref - breg;
                cend = cend_n;
                if (j > 1) { ra = *(const v4u*)(gA + (size_t)(j - 2) * 64 * N_FOX_MAIN); rb = *(const v4u*)(gB + (size_t)(j - 2) * 64 * N_FOX_MAIN); if (brole) breg = cum[(j - 2) * 64 + (tid - 256)]; cend_n = cum[(j - 2) * 64 + 63]; }
            }
            if (VAR == 0 && j <= jw && need) {
                attn_tile<1, false>(lds + (j & 1) * ABUF, qr, o, m, l, qpos, j * 64, r32, hi, j * 64 + 63 > R);
            }
        }
        attn_store(o, l, AO + tok * DM + h * 64, hi);
        if (tid == 0) uq[0] = unext;
        __syncthreads();
        ui = uq[0];
    }
    __syncthreads();
}

__device__ __forceinline__ void fox_cumsum_phase(const float* GATE, const float* bfv, float* CUM, const bf16* QKV, float* KPART, LAS unsigned char* lds) {
    const int tid = opaque_tid();
    const int lane = tid & 63, wave = tid >> 6;
    LAS double* wtot = (LAS double*)lds;
    { LAS float* wmax = (LAS float*)(lds + 256);
      for (int u = blockIdx.x; u < BATCH * NH * 4; u += gridDim.x) {
        const int bh = u >> 2, qtr = u & 3, b = bh >> 5, h = bh & 31;
        float mx = 0.f;
        for (int i = 0; i < 4; ++i) {
            const bf16* kp = QKV + ((size_t)b * SEQ + qtr * 2048 + i * 512 + tid) * N_FOX_MAIN + 2048 + h * 64;
            float ss = 0.f;
#pragma unroll
            for (int c = 0; c < 8; ++c) { const v4u w = *(const v4u*)(kp + c * 8); const unsigned ww[4] = {w.x, w.y, w.z, w.w};
#pragma unroll
                for (int e = 0; e < 4; ++e) { const float x0 = bf2f((unsigned short)(ww[e] & 0xffffu)), x1 = bf2f((unsigned short)(ww[e] >> 16)); ss += x0 * x0 + x1 * x1; } }
            mx = fmaxf(mx, ss);
        }
#pragma unroll
        for (int o = 1; o < 64; o <<= 1) mx = fmaxf(mx, __shfl_xor(mx, o));
        __syncthreads();
        if (lane == 0) wmax[wave] = mx;
        __syncthreads();
        if (tid == 0) { float t = wmax[0]; for (int w = 1; w < NWAVES; ++w) t = fmaxf(t, wmax[w]); KPART[u] = sqrtf(t); }
      }
      __syncthreads(); }
    for (int u = blockIdx.x; u < BATCH * NH; u += gridDim.x) {
        const int b = u >> 5, h = u & 31; const float bb = bfv[h];
        const float* gp = GATE + ((size_t)b * SEQ + tid * 16) * 32 + h;
        float v[16]; double acc = 0.0;
#pragma unroll
        for (int i = 0; i < 16; ++i) { const float z = gp[i * 32] + bb; const float lf = fminf(z, 0.f) - log1pf(expf(-fabsf(z))); acc += (double)lf; v[i] = (float)acc; }
        double incl = acc;
#pragma unroll
        for (int o = 1; o < 64; o <<= 1) { const double t = __shfl_up(incl, o); if (lane >= o) incl += t; }
        __syncthreads();
        if (lane == 63) wtot[wave] = incl;
        __syncthreads();
        double base = incl - acc;
        for (int w = 0; w < wave; ++w) base += wtot[w];
        float* cp = CUM + (size_t)u * SEQ + tid * 16;
#pragma unroll
        for (int i = 0; i < 16; ++i) cp[i] = (float)(base + (double)v[i]);
    }
    __syncthreads();
}

typedef __attribute__((address_space(1))) unsigned gu32;
#define XB_TMO      128
#define XB_XCNT(j)  (256  + 64 * (j))
#define XB_XSUB(j)  (1280 + 64 * (j))
#define XB_XGEN(j)  (2304 + 64 * (j))
#define XB_TOP      3328
#define XB_TOPGEN   3392
#define XCD_BAR_WORDS 3456
#define XB_SPIN_CAP (1u << 18)

__device__ __forceinline__ unsigned xb_ld(unsigned* p)              { return __hip_atomic_load(p, __ATOMIC_RELAXED, __HIP_MEMORY_SCOPE_AGENT); }
__device__ __forceinline__ unsigned xb_add(unsigned* p, unsigned v) { return __hip_atomic_fetch_add(p, v, __ATOMIC_RELAXED, __HIP_MEMORY_SCOPE_AGENT); }
__device__ __forceinline__ unsigned xb_xcc_id() { return (unsigned)__builtin_amdgcn_s_getreg((3 << 11) | 20) & 0xFu; }
#define XB_SPIN(cond, bar) do { unsigned _sp = 0; while (cond) { __builtin_amdgcn_s_sleep(1); \
    if ((++_sp & 255u) == 0u) { if (xb_ld(&(bar)[XB_TMO])) break; if (_sp > XB_SPIN_CAP) { atomicAdd(&(bar)[XB_TMO], 1u); break; } } } } while (0)

struct XcdBarrier {
    unsigned* bar; unsigned x;
    volatile LAS unsigned* st;
};

__device__ __forceinline__ XcdBarrier xcd_barrier_post(unsigned* bar, volatile LAS unsigned* st) {
    XcdBarrier b; b.bar = bar; b.x = xb_xcc_id(); b.st = st;
    if (threadIdx.x == 0) (void)xb_add(&bar[XB_XCNT(b.x)], 1u);
    return b;
}
__device__ __forceinline__ void xcd_barrier_complete(unsigned* bar, unsigned x, unsigned& nloc, unsigned& nx) {
    const unsigned G = gridDim.x * gridDim.y * gridDim.z;
    unsigned sum, cnt, mine, sp = 0u;
    for (;;) {
        sum = 0u; cnt = 0u; mine = 0u;
#pragma unroll
        for (unsigned j = 0; j < 16; ++j) { const unsigned c = xb_ld(&bar[XB_XCNT(j)]); sum += c; cnt += (c > 0u) ? 1u : 0u; mine = (j == x) ? c : mine; }
        if (sum == G) break;
        __builtin_amdgcn_s_sleep(1);
        if ((++sp & 255u) == 0u) { if (xb_ld(&bar[XB_TMO])) break; if (sp > XB_SPIN_CAP) { atomicAdd(&bar[XB_TMO], 1u); break; } }
    }
    nloc = mine > 0u ? mine : 1u; nx = cnt > 0u ? cnt : 1u;
}

__device__ __forceinline__ void xcd_barrier(const XcdBarrier& b) {
    asm volatile("s_waitcnt vmcnt(0)" ::: "memory");
    __syncthreads();
    if (threadIdx.x == 0) {
        unsigned* bar = b.bar;
        __builtin_amdgcn_s_waitcnt(0);
        unsigned nloc = b.st[0], nx = b.st[1];
        if (nloc == 0u) { xcd_barrier_complete(bar, b.x, nloc, nx); b.st[0] = nloc; b.st[1] = nx; }
        const unsigned old = xb_add(&bar[XB_XSUB(b.x)], 1u);
        const unsigned gen = old / nloc;
        if (old + 1u == (gen + 1u) * nloc) {
            __builtin_amdgcn_fence(__ATOMIC_RELEASE, "agent");
            asm volatile("s_waitcnt vmcnt(0)" ::: "memory");
            const unsigned og = xb_add(&bar[XB_TOP], 1u);
            const unsigned tg = og / nx;
            if (og + 1u == (tg + 1u) * nx) xb_add(&bar[XB_TOPGEN], 1u);
            else XB_SPIN(xb_ld(&bar[XB_TOPGEN]) == tg, bar);
            __builtin_amdgcn_fence(__ATOMIC_ACQUIRE, "agent");
            xb_add(&bar[XB_XGEN(b.x)], 1u);
            asm volatile("s_waitcnt vmcnt(0)" ::: "memory");
        } else {
            XB_SPIN(xb_ld(&bar[XB_XGEN(b.x)]) == gen, bar);
            __builtin_amdgcn_fence(__ATOMIC_ACQUIRE, "agent");
            asm volatile("s_waitcnt vmcnt(0)" ::: "memory");
        }
    }
    __syncthreads();
}

struct Args { const float* x; const int* pos; const float* gains; const float* swa_w_in; const float* swa_sinks; const float* swa_w_out; const float* fox_w_in; const float* fox_b_f; const float* fox_w_out;
              const float* w_gu; const float* w_dn; float* out; unsigned char* ws; };

__global__ void __launch_bounds__(NWAVES * 64, 2) mega_fwd(Args a) {
    extern __shared__ __attribute__((aligned(16))) unsigned char lds_raw[];
    cg::grid_group grid = cg::this_grid();
    LAS unsigned char* lds = (LAS unsigned char*)lds_raw;
    const int G = gridDim.x, bx = blockIdx.x;
    const int vcu = (G % 8 == 0) ? (bx % 8) * (G / 8) + bx / 8 : bx;
    const int NGW = G * NWAVES;
    unsigned char* ws = a.ws;
    bf16* WSI = (bf16*)(ws + WS_WSI); bf16* WSO = (bf16*)(ws + WS_WSO); bf16* WFI = (bf16*)(ws + WS_WFI); bf16* WFO = (bf16*)(ws + WS_WFO); bf16* WGU = (bf16*)(ws + WS_WGU); bf16* WDN = (bf16*)(ws + WS_WDN);
    bf16* XN = (bf16*)(ws + WS_XN); bf16* QKV = (bf16*)(ws + WS_QKV); bf16* HB = (bf16*)(ws + WS_HB); bf16* AO = (bf16*)(ws + WS_AO);
    float* Y = (float*)(ws + WS_Y); float* ROPE = (float*)(ws + WS_ROPE); float* GATE = (float*)(ws + WS_GATE); float* CUM = (float*)(ws + WS_CUM);

    volatile LAS unsigned* MISC = (volatile LAS unsigned*)(lds + MISC_OFF);
    if (threadIdx.x < 32) MISC[threadIdx.x] = 0u;
    __syncthreads();
    const XcdBarrier bar = xcd_barrier_post((unsigned*)(ws + WS_CTL), MISC + 8);
    for (int prorep = 0; prorep < PROBE_PROREP; ++prorep) {
        const int tid = opaque_tid(), lane = tid & 63, wave = __builtin_amdgcn_readfirstlane(tid >> 6), gw = vcu * NWAVES + wave;
        LAS float* scr = (LAS float*)(lds + wave * 16384);
        transpose_family<false>(a.swa_w_in, 2, DM, N_SWA_IN, WSI, (size_t)N_SWA_IN * DM, scr, gw, NGW, lane);
        transpose_family<false>(a.swa_w_out, 2, DM, DM, WSO, (size_t)DM * DM, scr, gw, NGW, lane);
        transpose_family<false>(a.fox_w_in, 2, DM, N_FOX_IN, WFI, (size_t)N_FOX_PAD * DM, scr, gw, NGW, lane);
        transpose_family<false>(a.fox_w_out, 2, DM, DM, WFO, (size_t)DM * DM, scr, gw, NGW, lane);
        transpose_family<true>(a.w_gu, 4, DM, N_GU, WGU, (size_t)N_GU * DM, scr, gw, NGW, lane);
        transpose_family<false>(a.w_dn, 4, DFF, DM, WDN, (size_t)DM * DFF, scr, gw, NGW, lane);
        for (int it = gw * 64 + lane; it < 2 * 57344; it += NGW * 64) { const int mi = it / 57344, r = it % 57344;
            *(v4u*)(WFI + (size_t)mi * N_FOX_PAD * DM + (size_t)N_FOX_IN * DM + (size_t)r * 8) = (v4u){0u, 0u, 0u, 0u}; }
        for (int it = gw * 64 + lane; it < M * 8; it += NGW * 64) { const int tk = it >> 3, i = it & 7;
            const float inv = powf(500000.0f, -(float)i * 0.125f); const float ang = (float)a.pos[tk] * inv;
            const double rev = (double)ang * 0.15915494309189535; const double fr = rev - rint(rev); const float rad = (float)(fr * 6.283185307179586);
            ROPE[it] = cosf(rad); ROPE[(size_t)M * 8 + it] = sinf(rad); }
        prenorm_rows(a.x, a.gains, XN, vcu, NGW);
    }
    if (gridDim.x > 0x40000000u) grid.sync();
    xcd_barrier(bar);

    for (int it = 0; it < 8 * DEPTH + PROBE_DUP; ++it) {
        const int ph = (PROBE_DUP && it > PROBE_PH) ? it - 1 : it;
        const int layer = ph >> 3, st = ph & 7, fox = layer & 1, j = layer >> 1;
        if (st == 1 && !fox) continue;
        const __attribute__((address_space(4))) Args* ka = (const __attribute__((address_space(4))) Args*)__builtin_amdgcn_kernarg_segment_ptr();
        asm volatile("" : "+s"(ka));
        unsigned char* ws = ka->ws;
        const int nrep = (st == PROBE_ST && (layer & 1) == PROBE_LAYER) ? 2 : 1;
        for (int rep = 0; rep < nrep; ++rep) {
        if (st == 0 || st == 3 || st == 5 || st == 6) {
            size_t aoff, boff, ooff; int N, K, mode, ldc, ntm = 1 << 30;
            if (st == 0) { aoff = WS_XN; ooff = WS_QKV; K = DM; mode = 0;
                if (!fox) { boff = WS_WSI + (size_t)j * N_SWA_IN * DM * 2; N = N_SWA_IN; ldc = N_SWA_IN; }
                else { boff = WS_WFI + (size_t)j * N_FOX_PAD * DM * 2; N = N_FOX_PAD; ldc = N_FOX_MAIN; ntm = N_FOX_MAIN / 256; } }
            else if (st == 3) { aoff = WS_AO; boff = (fox ? WS_WFO : WS_WSO) + (size_t)j * DM * DM * 2; ooff = WS_Y; N = DM; K = DM; mode = 1; ldc = DM; }
            else if (st == 5) { aoff = WS_XN; boff = WS_WGU + (size_t)layer * N_GU * DM * 2; ooff = WS_HB; N = N_GU; K = DM; mode = 2; ldc = DFF; }
            else { aoff = WS_HB; boff = WS_WDN + (size_t)layer * DM * DFF * 2; ooff = WS_Y; N = DM; K = DFF; mode = 1; ldc = DM; }
            pg8::Gemm gm{(const bf16*)(ws + aoff), (const bf16*)(ws + boff), M, N, K}; pg8::StaticOrder S; S.init(M, N, G, bx);
            pg8::EpiAny E{mode, true, ws + ooff, ldc, ntm, (float*)(ws + ((st == 0 && !fox) ? WS_ROPE : WS_GATE))};
            pg8::gemm_phase<pg8::EpiAny, pg8::StaticOrder, PG8_ALIGN, PG8_SP2>(lds, gm, S, E);
        } else if (st == 1) {
            fox_cumsum_phase((const float*)(ws + WS_GATE), ka->fox_b_f + j * NH, (float*)(ws + WS_CUM), (const bf16*)(ws + WS_QKV), (float*)(ws + WS_KPART), lds);
        } else if (st == 2) {
            if (!fox) swa_attn_phase((const bf16*)(ws + WS_QKV), ka->swa_sinks + j * NH, (bf16*)(ws + WS_AO), lds, vcu, G);
            else { fox_attn_phase<0>((const bf16*)(ws + WS_QKV), (const float*)(ws + WS_CUM), (const float*)(ws + WS_KPART), (bf16*)(ws + WS_AO), (int*)(ws + WS_KPART + 65536), (unsigned*)(ws + WS_CTL) + 4096 + 64 * j, lds, vcu, G);
                   }
        } else {
            const float* g = ka->gains + (size_t)layer * 4 * DM + (st == 4 ? DM : 3 * DM);
            float* outp = ka->out; const float* Xsrc = (ph == 4) ? ka->x : outp;
            post_rows(Xsrc, (const bf16*)(ws + WS_Y), g, g + DM, outp, (bf16*)(ws + WS_XN), ph != 8 * DEPTH - 1, vcu, NGW);
        }
        }
        if (it != 8 * DEPTH + PROBE_DUP - 1) { for (int r = 0; r < PROBE_NSYNC; ++r) xcd_barrier(bar); }
    }
}

extern "C" void kernel_launch(void* const* d_in, const int* in_sizes, int n_in, void* d_out, int out_size, void* d_ws, size_t ws_size, hipStream_t stream) {
    static int grid = 0;
    if (grid == 0) {
        if (n_in != 11 || in_sizes[0] != M * DM || out_size != M * DM || ws_size < WS_END) { fprintf(stderr, "kernel_launch: unexpected shapes (n_in %d, in0 %d, out %d, ws %zu); nothing launched\n", n_in, n_in > 0 ? in_sizes[0] : -1, out_size, ws_size); grid = -1; return; }
        int dev = 0, cus = 0, per_cu = 0;
        if (hipGetDevice(&dev) != hipSuccess || hipDeviceGetAttribute(&cus, hipDeviceAttributeMultiprocessorCount, dev) != hipSuccess) { grid = -1; return; }
        if (hipFuncSetAttribute((const void*)mega_fwd, hipFuncAttributeMaxDynamicSharedMemorySize, LDS_BYTES) != hipSuccess) { fprintf(stderr, "kernel_launch: hipFuncSetAttribute failed\n"); grid = -1; return; }
        if (hipOccupancyMaxActiveBlocksPerMultiprocessor(&per_cu, (const void*)mega_fwd, NWAVES * 64, LDS_BYTES) != hipSuccess || per_cu < 1) { fprintf(stderr, "kernel_launch: occupancy query says %d\n", per_cu); per_cu = 1; }
        (void)hipGetLastError();
        grid = cus * per_cu;
    }
    if (grid < 0) return;
    Args a{};
    a.x = (const float*)d_in[0]; a.pos = (const int*)d_in[1]; a.gains = (const float*)d_in[2]; a.swa_w_in = (const float*)d_in[3]; a.swa_sinks = (const float*)d_in[4]; a.swa_w_out = (const float*)d_in[5];
    a.fox_w_in = (const float*)d_in[6]; a.fox_b_f = (const float*)d_in[7]; a.fox_w_out = (const float*)d_in[8]; a.w_gu = (const float*)d_in[9]; a.w_dn = (const float*)d_in[10];
    a.out = (float*)d_out; a.ws = (unsigned char*)d_ws;
    if (hipMemsetAsync((char*)d_ws + WS_CTL, 0, (4096 + 128) * 4, stream) != hipSuccess) { fprintf(stderr, "kernel_launch: hipMemsetAsync failed\n"); return; }
    void* args[] = {&a};
    const hipError_t e = hipLaunchCooperativeKernel((const void*)mega_fwd, dim3(grid), dim3(NWAVES * 64), args, LDS_BYTES, stream);
    if (e != hipSuccess) fprintf(stderr, "kernel_launch: cooperative launch failed: %s (grid %d)\n", hipGetErrorString(e), grid);
}
```

```cpp
#include <hip/hip_runtime.h>
#include <hip/hip_cooperative_groups.h>
#include <cstdio>
#include <cstdint>
#include <cmath>
namespace cg = cooperative_groups;
namespace pg8 {
#define PG8_LAS __attribute__((address_space(3)))
typedef unsigned short bf16_t;
typedef short bf16x8 __attribute__((ext_vector_type(8)));
typedef float f32x4 __attribute__((ext_vector_type(4)));
typedef unsigned u32x4 __attribute__((ext_vector_type(4)));
constexpr int BM = 256, BK = 64, HALF = 128, HTB = HALF * BK * 2  , STAGE_BYTES = 8 * HTB, NXCD = 8, WGM = 8;

__host__ __device__ __forceinline__ int lds_byte(int r, int c) { const int st = (r >> 4) * 2 + (c >> 5), rr = r & 15, cc = c & 31, ob = rr * 64 + cc * 2; return st * 1024 + (ob ^ (((ob >> 9) & 1) << 5)); }
__host__ __device__ __forceinline__ void stage_rc(int b, int& R, int& C) { const int st = b / 1024, sb = b % 1024, swz = sb ^ (((sb >> 9) & 1) << 5); R = (st >> 1) * 16 + swz / 64; C = (st & 1) * 32 + (swz % 64) / 2; }
__host__ __device__ __forceinline__ int perm32(int rho) { const int n = rho >> 4, i = rho & 15; return 8 * (i >> 2) + 4 * n + (i & 3); }

struct Unit { int pm, pn; };
struct Gemm { const bf16_t* A; const bf16_t* Bt; int M, N, K; };

struct StaticOrder {
    int nM, nN, nwg, G, c;
    __host__ __device__ void init(int M, int N, int G_, int c_) { nM = M / BM; nN = N / BM; nwg = nM * nN; G = G_; c = c_; }
    __host__ __device__ bool next(int i, Unit& u) const {
        const long L = (long)i * G + c; if (L >= nwg) return false;
        int wgid = (int)L; { const int q = nwg / NXCD, r = nwg % NXCD, xcd = wgid % NXCD, off = wgid / NXCD; wgid = (xcd < r ? xcd * (q + 1) : r * (q + 1) + (xcd - r) * q) + off; }
        const int nig = WGM * nN, gid = wgid / nig, fm = gid * WGM, gsz = (nM - fm) < WGM ? (nM - fm) : WGM;
        u.pm = fm + ((wgid % nig) % gsz); u.pn = (wgid % nig) / gsz; return true;
    }
    __device__ __forceinline__ void a_ready(const Unit&) const {}
    __device__ __forceinline__ void done(const Unit&) const {}
};

__device__ __forceinline__ unsigned cvt_pk_bf16(float lo, float hi) { unsigned r; asm volatile("v_cvt_pk_bf16_f32 %0, %1, %2" : "=v"(r) : "v"(lo), "v"(hi)); return r; }
typedef float f32x2 __attribute__((ext_vector_type(2)));
struct EpiQKV {
    static constexpr bool PERM = true, AFTER_DRAIN = false;
    bf16_t* O; int ldc; int ntile_main; float* G;
    __device__ __forceinline__ void plain(const f32x4 (&acc)[2][2][4][2], const Unit& u, int wr, int wc, int fr, int fq) const {
        const int row0 = u.pm * BM + wr * 64 + fr, col0 = u.pn * BM + wc * 32 + 8 * fq;
#pragma unroll
        for (int ai = 0; ai < 2; ++ai)
#pragma unroll
            for (int m = 0; m < 4; ++m) { bf16_t* rowp = O + (size_t)(row0 + ai * HALF + m * 16) * ldc + col0;
#pragma unroll
                for (int bj = 0; bj < 2; ++bj) { const f32x4 v0 = acc[ai][bj][m][0], v1 = acc[ai][bj][m][1];
                    u32x4 w; w.x = cvt_pk_bf16(v0[0], v0[1]); w.y = cvt_pk_bf16(v0[2], v0[3]); w.z = cvt_pk_bf16(v1[0], v1[1]); w.w = cvt_pk_bf16(v1[2], v1[3]);
                    *(u32x4*)(rowp + bj * HALF) = w; } }
    }
    __device__ __forceinline__ void operator()(const f32x4 (&acc)[2][2][4][2], const Unit& u, int wr, int wc, int fr, int fq) const {
        const int row0 = u.pm * BM + wr * 64 + fr;
        if (u.pn < ntile_main) {
            const int col0 = u.pn * BM + wc * 32 + 8 * fq;
            const bool rot = (ntile_main > 4096) && (u.pn < 10) && ((wc & 1) == 0);
            const float sg = fq == 0 ? -1.f : 1.f;
#pragma unroll
            for (int ai = 0; ai < 2; ++ai)
#pragma unroll
                for (int m = 0; m < 4; ++m) { const int row = row0 + ai * HALF + m * 16; bf16_t* rowp = O + (size_t)row * ldc + col0;
                    f32x4 c0 = {1.f, 1.f, 1.f, 1.f}, c1 = c0, s0 = {0.f, 0.f, 0.f, 0.f}, s1 = s0;
                    if (rot) { const float* cp = G + (size_t)row * 8; c0 = *(const f32x4*)cp; c1 = *(const f32x4*)(cp + 4); s0 = *(const f32x4*)(cp + 131072); s1 = *(const f32x4*)(cp + 131072 + 4); }
#pragma unroll
                    for (int bj = 0; bj < 2; ++bj) { f32x4 v0 = acc[ai][bj][m][0], v1 = acc[ai][bj][m][1];
                        if (rot) { f32x4 q0, q1;
#pragma unroll
                            for (int e = 0; e < 4; ++e) { q0[e] = __shfl_xor(v0[e], 16); q1[e] = __shfl_xor(v1[e], 16); }
                            if (fq < 2) { v0 = v0 * c0 + sg * q0 * s0; v1 = v1 * c1 + sg * q1 * s1; } }
                        u32x4 w; w.x = cvt_pk_bf16(v0[0], v0[1]); w.y = cvt_pk_bf16(v0[2], v0[3]); w.z = cvt_pk_bf16(v1[0], v1[1]); w.w = cvt_pk_bf16(v1[2], v1[3]);
                        *(u32x4*)(rowp + bj * HALF) = w; } }
        } else if (wc == 0) {
#pragma unroll
            for (int ai = 0; ai < 2; ++ai)
#pragma unroll
                for (int m = 0; m < 4; ++m) { float* gp = G + (size_t)(row0 + ai * HALF + m * 16) * 32 + 8 * fq;
                    *(f32x4*)gp = acc[ai][0][m][0]; *(f32x4*)(gp + 4) = acc[ai][0][m][1]; }
        }
    }
};
struct EpiF32 {
    static constexpr bool PERM = false, AFTER_DRAIN = false;
    float* Y; int ldc;
    __device__ __forceinline__ void operator()(const f32x4 (&acc)[2][2][4][2], const Unit& u, int wr, int wc, int fr, int fq) const {
        const int row0 = u.pm * BM + wr * 64 + fr, col0 = u.pn * BM + wc * 32 + 4 * fq;
#pragma unroll
        for (int ai = 0; ai < 2; ++ai)
#pragma unroll
            for (int m = 0; m < 4; ++m) { float* rowp = Y + (size_t)(row0 + ai * HALF + m * 16) * ldc + col0;
#pragma unroll
                for (int bj = 0; bj < 2; ++bj)
#pragma unroll
                    for (int n = 0; n < 2; ++n) *(f32x4*)(rowp + bj * HALF + n * 16) = acc[ai][bj][m][n]; }
    }
};
struct EpiSwiGLU {
    static constexpr bool PERM = true, AFTER_DRAIN = false;
    bf16_t* Hout; int ldc;
    static __device__ __forceinline__ float sw(float g, float up) { return g * __builtin_amdgcn_rcpf(1.0f + __builtin_amdgcn_exp2f(-1.4426950408889634f * g)) * up; }
    __device__ __forceinline__ void operator()(const f32x4 (&acc)[2][2][4][2], const Unit& u, int wr, int wc, int fr, int fq) const {
        const int row0 = u.pm * BM + wr * 64 + fr, col0 = u.pn * HALF + wc * 32 + 8 * fq;
#pragma unroll
        for (int ai = 0; ai < 2; ++ai)
#pragma unroll
            for (int m = 0; m < 4; ++m) { bf16_t* rowp = Hout + (size_t)(row0 + ai * HALF + m * 16) * ldc + col0;
                const f32x4 g0 = acc[ai][0][m][0], g1 = acc[ai][0][m][1], u0 = acc[ai][1][m][0], u1 = acc[ai][1][m][1];
                u32x4 w; w.x = cvt_pk_bf16(sw(g0[0], u0[0]), sw(g0[1], u0[1])); w.y = cvt_pk_bf16(sw(g0[2], u0[2]), sw(g0[3], u0[3]));
                w.z = cvt_pk_bf16(sw(g1[0], u1[0]), sw(g1[1], u1[1])); w.w = cvt_pk_bf16(sw(g1[2], u1[2]), sw(g1[3], u1[3]));
                *(u32x4*)rowp = w; }
    }
};

struct EpiAny {
    static constexpr bool AFTER_DRAIN = false;
    int mode; bool PERM; unsigned char* O; int ldc; int ntile_main; float* G;
    __device__ __forceinline__ void operator()(const f32x4 (&acc)[2][2][4][2], const Unit& u, int wr, int wc, int fr, int fq) const {
        if (mode == 0) { EpiQKV e{(bf16_t*)O, ldc, ntile_main, G}; e(acc, u, wr, wc, fr, fq); }
        else if (mode == 1) { EpiQKV e{(bf16_t*)O, ldc, 1 << 20, nullptr}; e.plain(acc, u, wr, wc, fr, fq); }
        else { EpiSwiGLU e{(bf16_t*)O, ldc}; e(acc, u, wr, wc, fr, fq); }
    }
};

template <class Epi, class Sched, bool ALIGN_EPI = false, bool SP2 = false>
__device__ __forceinline__ void gemm_phase(PG8_LAS unsigned char* lds, const Gemm g, const Sched& S, const Epi& E) {
    const int tid = threadIdx.x, wid = __builtin_amdgcn_readfirstlane(tid >> 6), lane = tid & 63, wr = wid >> 2, wc = wid & 3, fr = lane & 15, fq = lane >> 4;
    const int K = g.K, nt = K / BK;
    unsigned voffA[2], voffB[2];
#pragma unroll
    for (int i = 0; i < 2; ++i) { int R, C; stage_rc(tid * 16 + i * 8192, R, C); const int Rb = E.PERM ? ((R & ~31) + perm32(R & 31)) : R;
        voffA[i] = (unsigned)(R * K + C) * 2u; voffB[i] = (unsigned)(Rb * K + C) * 2u; }
    const size_t kstep = (size_t)(BK * 2);
    const size_t hstep = (size_t)HALF * K * 2;
    const size_t tstep = 2 * hstep;
    const unsigned ldsw = (unsigned)wid * 1024u;
    const int aoff = lds_byte(wr * 64 + fr, fq * 8), boff = lds_byte(wc * 32 + fr, fq * 8);
#define PG8_SA(b, h) (((b) * 2 + (h)) * HTB)
#define PG8_SB(b, h) ((4 + (b) * 2 + (h)) * HTB)
#define PG8_STAGE(bufoff, gbase, voff) do { _Pragma("unroll") for (int _i = 0; _i < 2; ++_i) \
        __builtin_amdgcn_global_load_lds((const unsigned*)((const char*)(gbase) + (voff)[_i]), (PG8_LAS unsigned*)(lds + (bufoff) + ldsw + _i * 8192), 16, 0, 0); } while (0)
#define PG8_LDA(dst, b, h) do { _Pragma("unroll") for (int m = 0; m < 4; ++m) _Pragma("unroll") for (int k = 0; k < 2; ++k) dst[m][k] = *(const PG8_LAS bf16x8*)(lds + PG8_SA(b, h) + aoff + m * 2048 + k * 1024); } while (0)
#define PG8_LDB(dst, b, h) do { _Pragma("unroll") for (int n = 0; n < 2; ++n) _Pragma("unroll") for (int k = 0; k < 2; ++k) dst[n][k] = *(const PG8_LAS bf16x8*)(lds + PG8_SB(b, h) + boff + n * 2048 + k * 1024); } while (0)
#define PG8_MMA(ai, bj, At, Bt) do { __builtin_amdgcn_s_setprio(1); _Pragma("unroll") for (int m = 0; m < 4; ++m) _Pragma("unroll") for (int n = 0; n < 2; ++n) _Pragma("unroll") for (int k = 0; k < 2; ++k) \
        acc[ai][bj][m][n] = __builtin_amdgcn_mfma_f32_16x16x32_bf16(Bt[n][k], At[m][k], acc[ai][bj][m][n], 0, 0, 0); __builtin_amdgcn_s_setprio(0); } while (0)
#define PG8_WAIT_V(n) asm volatile("s_waitcnt vmcnt(" #n ")" ::: "memory")
#define PG8_WAIT_L(n) asm volatile("s_waitcnt lgkmcnt(" #n ")" ::: "memory")
#define PG8_BAR __builtin_amdgcn_s_barrier()
#define PG8_SCHED __builtin_amdgcn_sched_barrier(0)
    Unit cur, nxt; int ui = 0;
    if (!S.next(0, cur)) return;
    f32x4 acc[2][2][4][2];
#pragma unroll
    for (int a = 0; a < 2; ++a)
#pragma unroll
        for (int b = 0; b < 2; ++b)
#pragma unroll
            for (int m = 0; m < 4; ++m)
#pragma unroll
                for (int n = 0; n < 2; ++n) acc[a][b][m][n] = (f32x4){0.f, 0.f, 0.f, 0.f};
    bf16x8 At[4][2], B0[2][2], B1[2][2];
    const char* cA = (const char*)g.A + (size_t)cur.pm * tstep; const char* cB = (const char*)g.Bt + (size_t)cur.pn * tstep;
    S.a_ready(cur);
    if constexpr (SP2) {
        PG8_STAGE(PG8_SB(0, 0), cB, voffB); PG8_STAGE(PG8_SB(0, 1), cB + hstep, voffB); PG8_STAGE(PG8_SA(0, 0), cA, voffA); PG8_STAGE(PG8_SA(0, 1), cA + hstep, voffA);
        if (wr == 1) PG8_BAR;
        PG8_WAIT_V(2); PG8_BAR;
        PG8_STAGE(PG8_SB(1, 0), cB + kstep, voffB); PG8_STAGE(PG8_SA(1, 0), cA + kstep, voffA); PG8_STAGE(PG8_SB(1, 1), cB + hstep + kstep, voffB);
        PG8_WAIT_V(6); PG8_BAR;
    } else {
        PG8_STAGE(PG8_SB(0, 0), cB, voffB); PG8_STAGE(PG8_SA(0, 0), cA, voffA); PG8_STAGE(PG8_SB(0, 1), cB + hstep, voffB); PG8_STAGE(PG8_SA(0, 1), cA + hstep, voffA);
        if (wr == 1) PG8_BAR;
        PG8_WAIT_V(4); PG8_BAR;
        PG8_STAGE(PG8_SB(1, 0), cB + kstep, voffB); PG8_STAGE(PG8_SA(1, 0), cA + kstep, voffA); PG8_STAGE(PG8_SB(1, 1), cB + hstep + kstep, voffB);
        PG8_WAIT_V(6); PG8_BAR;
    }
    for (;;) {
        const bool has_next = S.next(ui + 1, nxt);
        const char* nA = has_next ? (const char*)g.A + (size_t)nxt.pm * tstep : cA; const char* nB = has_next ? (const char*)g.Bt + (size_t)nxt.pn * tstep : cB;
        for (int t = 0; t < nt; t += 2) {
            const bool last = (t == nt - 2);
            const char* a1 = cA + (size_t)(t + 1) * kstep;
            const char* a2 = last ? nA : cA + (size_t)(t + 2) * kstep; const char* b2 = last ? nB : cB + (size_t)(t + 2) * kstep;
            const char* a3 = a2 + kstep; const char* b3 = b2 + kstep;
            if (last && has_next) S.a_ready(nxt);
            if constexpr (SP2) {
            PG8_LDB(B0, 0, 0); PG8_LDB(B1, 0, 1); PG8_SCHED; PG8_LDA(At, 0, 0); PG8_STAGE(PG8_SA(1, 1), a1 + hstep, voffA);
            PG8_WAIT_V(8); PG8_WAIT_L(0); PG8_BAR; PG8_MMA(0, 0, At, B0); PG8_MMA(0, 1, At, B1); PG8_BAR; PG8_SCHED;
            PG8_LDA(At, 0, 1); PG8_STAGE(PG8_SB(0, 0), b2, voffB); PG8_STAGE(PG8_SB(0, 1), b2 + hstep, voffB); PG8_STAGE(PG8_SA(0, 0), a2, voffA);
            PG8_WAIT_V(8); PG8_WAIT_L(0); PG8_BAR; PG8_MMA(1, 0, At, B0); PG8_MMA(1, 1, At, B1); PG8_BAR; PG8_SCHED;
            PG8_LDB(B0, 1, 0); PG8_LDB(B1, 1, 1); PG8_SCHED; PG8_LDA(At, 1, 0); PG8_STAGE(PG8_SA(0, 1), a2 + hstep, voffA);
            PG8_WAIT_V(8); PG8_WAIT_L(0); PG8_BAR; PG8_MMA(0, 0, At, B0); PG8_MMA(0, 1, At, B1); PG8_BAR; PG8_SCHED;
            PG8_LDA(At, 1, 1); PG8_STAGE(PG8_SB(1, 0), b3, voffB); PG8_STAGE(PG8_SB(1, 1), b3 + hstep, voffB); PG8_STAGE(PG8_SA(1, 0), a3, voffA);
            PG8_WAIT_V(8); PG8_WAIT_L(0); PG8_BAR; PG8_MMA(1, 0, At, B0); PG8_MMA(1, 1, At, B1); PG8_BAR; PG8_SCHED;
            } else {
            PG8_LDB(B0, 0, 0); PG8_SCHED; PG8_LDA(At, 0, 0); PG8_STAGE(PG8_SA(1, 1), a1 + hstep, voffA);
            PG8_WAIT_L(8); PG8_BAR; PG8_WAIT_L(0); PG8_MMA(0, 0, At, B0); PG8_BAR; PG8_SCHED;
            PG8_LDB(B1, 0, 1); PG8_STAGE(PG8_SB(0, 0), b2, voffB);
            PG8_BAR; PG8_WAIT_L(0); PG8_MMA(0, 1, At, B1); PG8_BAR;
            PG8_LDA(At, 0, 1); PG8_STAGE(PG8_SA(0, 0), a2, voffA);
            PG8_BAR; PG8_WAIT_L(0); PG8_MMA(1, 0, At, B0); PG8_BAR; PG8_SCHED;
            PG8_STAGE(PG8_SB(0, 1), b2 + hstep, voffB);
            PG8_WAIT_V(6); PG8_BAR; PG8_MMA(1, 1, At, B1); PG8_BAR;
            PG8_LDB(B0, 1, 0); PG8_SCHED; PG8_LDA(At, 1, 0); PG8_STAGE(PG8_SA(0, 1), a2 + hstep, voffA);
            PG8_WAIT_L(8); PG8_BAR; PG8_WAIT_L(0); PG8_MMA(0, 0, At, B0); PG8_BAR; PG8_SCHED;
            PG8_LDB(B1, 1, 1); PG8_STAGE(PG8_SB(1, 0), b3, voffB);
            PG8_BAR; PG8_WAIT_L(0); PG8_MMA(0, 1, At, B1); PG8_BAR;
            PG8_LDA(At, 1, 1); PG8_STAGE(PG8_SA(1, 0), a3, voffA);
            PG8_BAR; PG8_WAIT_L(0); PG8_MMA(1, 0, At, B0); PG8_BAR; PG8_SCHED;
            PG8_STAGE(PG8_SB(1, 1), b3 + hstep, voffB);
            PG8_WAIT_V(6); PG8_BAR; PG8_MMA(1, 1, At, B1); PG8_BAR;
            }
        }
        if constexpr (ALIGN_EPI) { if (wr == 0) PG8_BAR; }
        if constexpr (!Epi::AFTER_DRAIN) { E(acc, cur, wr, wc, fr, fq); S.done(cur); }
        if (!has_next) break;
#pragma unroll
        for (int a = 0; a < 2; ++a)
#pragma unroll
            for (int b = 0; b < 2; ++b)
#pragma unroll
                for (int m = 0; m < 4; ++m)
#pragma unroll
                    for (int n = 0; n < 2; ++n) acc[a][b][m][n] = (f32x4){0.f, 0.f, 0.f, 0.f};
        cur = nxt; cA = nA; cB = nB; ++ui;
        if constexpr (ALIGN_EPI) { if (wr == 1) PG8_BAR; }
    }
    PG8_WAIT_V(0);
    if constexpr (!ALIGN_EPI) { if (wr == 0) PG8_BAR; }
    PG8_BAR;
    if constexpr (Epi::AFTER_DRAIN) { E.fused(acc, cur, wr, wc, fr, fq, lds, wid, lane); S.done(cur); }
#undef PG8_SA
#undef PG8_SB
#undef PG8_STAGE
#undef PG8_LDA
#undef PG8_LDB
#undef PG8_MMA
#undef PG8_WAIT_V
#undef PG8_WAIT_L
#undef PG8_BAR
#undef PG8_SCHED
}
}
#define PG8_ALIGN true
#ifndef PROBE_ST
#define PROBE_ST -1
#define PROBE_LAYER 1
#define PROBE_NSYNC 1
#define PROBE_DUP 0
#define PROBE_PH 8
#define PROBE_FOXREP 1
#define PROBE_FOXVAR 0
#define PROBE_PROREP 1
#define PROBE_SWAREP 1
#endif
#define PG8_SP2 true
constexpr int NWAVES = 8;
constexpr int BATCH = 2, SEQ = 8192, DM = 2048, M = BATCH * SEQ, NH = 32, HD = 64, KVH = 8, DFF = 5632, DEPTH = 4;
constexpr int N_SWA_IN = 3072, N_FOX_IN = 6176, N_FOX_PAD = 6400, N_FOX_MAIN = 6144, N_GU = 2 * DFF;
constexpr float RMS_EPS = 1e-6f, LOG2E = 1.4426950408889634f, C2 = 0.125f * 1.4426950408889634f;
constexpr size_t MiB = 1u << 20; constexpr int RING_BYTES_C = 131072;
constexpr size_t WS_CTL = 0;
constexpr int MISC_OFF = RING_BYTES_C + 320;
constexpr size_t WS_ROPE = 1 * MiB, WS_GATE = 2 * MiB, WS_CUM = 4 * MiB, WS_KPART = 6 * MiB;
constexpr size_t WS_WSI = 8 * MiB, WS_WSO = 32 * MiB, WS_WFI = 48 * MiB, WS_WFO = 98 * MiB, WS_WGU = 114 * MiB, WS_WDN = 290 * MiB;
constexpr size_t WS_XN = 378 * MiB, WS_QKV = 442 * MiB, WS_HB = WS_QKV, WS_AO = 634 * MiB, WS_Y = 698 * MiB, WS_END = 826 * MiB;
static_assert(WS_WSI + 2ull * N_SWA_IN * DM * 2 <= WS_WSO && WS_WSO + 2ull * DM * DM * 2 <= WS_WFI && WS_WFI + 2ull * N_FOX_PAD * DM * 2 <= WS_WFO && WS_WFO + 2ull * DM * DM * 2 <= WS_WGU
              && WS_WGU + 4ull * N_GU * DM * 2 <= WS_WDN && WS_WDN + 4ull * DM * DFF * 2 <= WS_XN && WS_XN + (size_t)M * DM * 2 <= WS_QKV && WS_QKV + (size_t)M * N_FOX_MAIN * 2 <= WS_AO
              && WS_HB + (size_t)M * DFF * 2 <= WS_AO && WS_AO + (size_t)M * DM * 2 <= WS_Y && WS_Y + (size_t)M * DM * 2 <= WS_END, "d_ws map");
constexpr int RING_BYTES = 131072, LDS_BYTES = 147456;

#define LAS __attribute__((address_space(3)))
typedef unsigned short bf16;
typedef unsigned v4u __attribute__((ext_vector_type(4)));
typedef unsigned v2u __attribute__((ext_vector_type(2)));
typedef float f32x4 __attribute__((ext_vector_type(4)));
typedef float f32x16 __attribute__((ext_vector_type(16)));
typedef short bf16x8 __attribute__((ext_vector_type(8)));
typedef short s16x4 __attribute__((ext_vector_type(4)));
#define LDS_WAIT() asm volatile("s_waitcnt lgkmcnt(0)" ::: "memory")
__device__ __forceinline__ unsigned f2bf(float f) { unsigned u = __builtin_bit_cast(unsigned, f); return (u + 0x7fffu + ((u >> 16) & 1u)) >> 16; }
__device__ __forceinline__ unsigned pk2(float lo, float hi) { return f2bf(lo) | (f2bf(hi) << 16); }
typedef float f32x2_t __attribute__((ext_vector_type(2))); typedef __bf16 bf16x2_t __attribute__((ext_vector_type(2)));
__device__ __forceinline__ unsigned cvtpk(float lo, float hi) { f32x2_t v = {lo, hi}; bf16x2_t b = __builtin_convertvector(v, bf16x2_t); return __builtin_bit_cast(unsigned, b); }
__device__ __forceinline__ float bf2f(unsigned short b) { return __builtin_bit_cast(float, (unsigned)b << 16); }
__device__ __forceinline__ float wave_sum(float v) {
#pragma unroll
    for (int o = 1; o < 64; o <<= 1) v += __shfl_xor(v, o);
    return v;
}

__device__ __forceinline__ int opaque_tid() { int t = threadIdx.x; asm volatile("" : "+v"(t)); return t; }
__device__ __forceinline__ void transpose_item(const float* W, int K, int N, bf16* WT, int k0, int n0, int drow0, LAS float* scr, int lane) {
#pragma unroll 16
    for (int i = 0; i < 32; ++i) { const int kk = 2 * i + (lane >> 5); scr[kk * 33 + (lane & 31)] = __builtin_nontemporal_load(W + (size_t)(k0 + kk) * N + n0 + (lane & 31)); }
    LDS_WAIT(); asm volatile("" ::: "memory");
    const int c = lane & 7;
#pragma unroll
    for (int j = 0; j < 4; ++j) { const int n = (lane >> 3) + 8 * j; const LAS float* s = scr + (8 * c) * 33 + n;
        v4u o; o.x = pk2(s[0 * 33], s[1 * 33]); o.y = pk2(s[2 * 33], s[3 * 33]); o.z = pk2(s[4 * 33], s[5 * 33]); o.w = pk2(s[6 * 33], s[7 * 33]);
        __builtin_nontemporal_store(o, (v4u*)(WT + (size_t)(drow0 + n) * K + k0 + 8 * c)); }
    LDS_WAIT(); asm volatile("" ::: "memory");
}
template <bool GU>
__device__ __forceinline__ void transpose_family(const float* W, int nmat, int K, int N, bf16* WT, size_t dstride, LAS float* scr, int gw, int NGW, int lane) {
    const int nblk = N / 32, per = (K / 64) * nblk, total = nmat * per;
    for (int it = gw; it < total; it += NGW) {
        const int mi = it / per, r = it % per, kb = r / nblk, nb = r % nblk, n0 = nb * 32;
        int drow0 = n0;
        if (GU) { const int j = n0 < DFF ? n0 : n0 - DFF; drow0 = (j >> 7) * 256 + (n0 < DFF ? 0 : 128) + (j & 127); }
        transpose_item(W + (size_t)mi * K * N, K, N, WT + (size_t)mi * dstride, kb * 64, n0, drow0, scr, lane);
    }
}
__device__ __forceinline__ void prenorm_rows(const float* X, const float* g, bf16* XN, int vcu, int NGW) {
    const int tid = opaque_tid(), lane = tid & 63, gw = vcu * NWAVES + __builtin_amdgcn_readfirstlane(tid >> 6);
    for (int m = gw; m < M; m += NGW) {
        const f32x4* xr = (const f32x4*)(X + (size_t)m * DM) + lane;
        f32x4 x[8]; float ss = 0.f;
#pragma unroll
        for (int j = 0; j < 8; ++j) { x[j] = __builtin_nontemporal_load(xr + 64 * j); ss += (x[j].x * x[j].x + x[j].y * x[j].y) + (x[j].z * x[j].z + x[j].w * x[j].w); }
        const float r = 1.0f / sqrtf(wave_sum(ss) * (1.0f / DM) + RMS_EPS);
        v2u* o8 = (v2u*)(XN + (size_t)m * DM) + lane;
#pragma unroll
        for (int j = 0; j < 8; ++j) { const f32x4 gg = ((const f32x4*)g)[lane + 64 * j]; v2u w; w.x = pk2(x[j].x * r * gg.x, x[j].y * r * gg.y); w.y = pk2(x[j].z * r * gg.z, x[j].w * r * gg.w); o8[64 * j] = w; }
    }
}
__device__ __forceinline__ void post_rows(const float* Xsrc, const bf16* Y, const float* g1, const float* g2, float* Xdst, bf16* XN, bool do_next, int vcu, int NGW) {
    const int tid = opaque_tid(), lane = tid & 63, gw = vcu * NWAVES + __builtin_amdgcn_readfirstlane(tid >> 6);
    v2u yw[8], ywn[8]; f32x4 x[8], xn[8], gg1[8], gg2[8];
#pragma unroll
    for (int j = 0; j < 8; ++j) { gg1[j] = ((const f32x4*)g1)[lane + 64 * j]; gg2[j] = do_next ? ((const f32x4*)g2)[lane + 64 * j] : gg1[j]; }
    if (gw < M) {
        const v2u* yr = (const v2u*)(Y + (size_t)gw * DM) + lane; const f32x4* xr = (const f32x4*)(Xsrc + (size_t)gw * DM) + lane;
#pragma unroll
        for (int j = 0; j < 8; ++j) { ywn[j] = __builtin_nontemporal_load(yr + 64 * j); xn[j] = __builtin_nontemporal_load(xr + 64 * j); }
    }
    for (int m = gw; m < M; m += NGW) {
#pragma unroll
        for (int j = 0; j < 8; ++j) { yw[j] = ywn[j]; x[j] = xn[j]; }
        if (m + NGW < M) {
            const v2u* yr = (const v2u*)(Y + (size_t)(m + NGW) * DM) + lane; const f32x4* xr = (const f32x4*)(Xsrc + (size_t)(m + NGW) * DM) + lane;
#pragma unroll
            for (int j = 0; j < 8; ++j) { ywn[j] = __builtin_nontemporal_load(yr + 64 * j); xn[j] = __builtin_nontemporal_load(xr + 64 * j); }
        }
        f32x4* xo = (f32x4*)(Xdst + (size_t)m * DM) + lane;
        f32x4 y[8]; float ss = 0.f;
#pragma unroll
        for (int j = 0; j < 8; ++j) { const v2u w = yw[j]; y[j] = (f32x4){bf2f((unsigned short)(w.x & 0xffffu)), bf2f((unsigned short)(w.x >> 16)), bf2f((unsigned short)(w.y & 0xffffu)), bf2f((unsigned short)(w.y >> 16))};
            ss += (y[j].x * y[j].x + y[j].y * y[j].y) + (y[j].z * y[j].z + y[j].w * y[j].w); }
        const float r1 = 1.0f / sqrtf(wave_sum(ss) * (1.0f / DM) + RMS_EPS);
        float s2 = 0.f;
#pragma unroll
        for (int j = 0; j < 8; ++j) { const f32x4 gg = gg1[j]; x[j] = x[j] + y[j] * r1 * gg; s2 += (x[j].x * x[j].x + x[j].y * x[j].y) + (x[j].z * x[j].z + x[j].w * x[j].w); __builtin_nontemporal_store(x[j], xo + 64 * j); }
        if (do_next) {
            const float r2 = 1.0f / sqrtf(wave_sum(s2) * (1.0f / DM) + RMS_EPS);
            v2u* o8 = (v2u*)(XN + (size_t)m * DM) + lane;
#pragma unroll
            for (int j = 0; j < 8; ++j) { const f32x4 gg = gg2[j]; v2u w; w.x = cvtpk(x[j].x * r2 * gg.x, x[j].y * r2 * gg.y); w.y = cvtpk(x[j].z * r2 * gg.z, x[j].w * r2 * gg.w); o8[64 * j] = w; }
        }
    }
}

constexpr int KS_PITCH = 144, VT_PITCH = 136, OFF_VT = 9216, OFF_BS = 17920, ABUF = 18432;
__device__ __forceinline__ float max3f(float a, float b, float c) { float r; asm("v_max3_f32 %0, %1, %2, %3" : "=v"(r) : "v"(a), "v"(b), "v"(c)); return r; }
__device__ __forceinline__ float max2f(float a, float b) { float r; asm("v_max_f32_e32 %0, %1, %2" : "=v"(r) : "v"(a), "v"(b)); return r; }
__device__ __forceinline__ float xhalf_max(float v) { auto rr = __builtin_amdgcn_permlane32_swap(__float_as_uint(v), __float_as_uint(v), false, false); return max2f(__uint_as_float(rr[0]), __uint_as_float(rr[1])); }
__device__ __forceinline__ bf16x8 scale_q(v4u w) {
    const unsigned ww[4] = {w.x, w.y, w.z, w.w}; unsigned r[4];
#pragma unroll
    for (int i = 0; i < 4; ++i) r[i] = cvtpk(bf2f((unsigned short)(ww[i] & 0xffffu)) * 0.125f, bf2f((unsigned short)(ww[i] >> 16)) * 0.125f);
    v4u o; o.x = r[0]; o.y = r[1]; o.z = r[2]; o.w = r[3]; return __builtin_bit_cast(bf16x8, o);
}
template <int MODE, bool WINDOW>
__device__ __forceinline__ void attn_tile(const LAS unsigned char* buf, const bf16x8* qr, f32x16* o, float& m, float& l, int qpos, int kbase, int r32, int hi, const bool CAUSAL) {
    const LAS unsigned char* Ks = buf; const LAS unsigned char* Vt = buf + OFF_VT; const LAS float* Bs = (const LAS float*)(buf + OFF_BS);
    f32x16 p0, p1;
    if (MODE == 1) {
#pragma unroll
        for (int g = 0; g < 4; ++g) { const f32x4 b0 = *(const LAS f32x4*)(Bs + 8 * g + 4 * hi), b1 = *(const LAS f32x4*)(Bs + 32 + 8 * g + 4 * hi);
#pragma unroll
            for (int e = 0; e < 4; ++e) { p0[4 * g + e] = b0[e]; p1[4 * g + e] = b1[e]; } }
    } else {
#pragma unroll
        for (int r = 0; r < 16; ++r) { p0[r] = 0.f; p1[r] = 0.f; }
    }
#pragma unroll
    for (int d0 = 0; d0 < 4; ++d0) {
        const bf16x8 a0 = *(const LAS bf16x8*)(Ks + r32 * KS_PITCH + d0 * 32 + hi * 16);
        const bf16x8 a1 = *(const LAS bf16x8*)(Ks + (32 + r32) * KS_PITCH + d0 * 32 + hi * 16);
        p0 = __builtin_amdgcn_mfma_f32_32x32x16_bf16(a0, qr[d0], p0, 0, 0, 0);
        p1 = __builtin_amdgcn_mfma_f32_32x32x16_bf16(a1, qr[d0], p1, 0, 0, 0);
    }
    if (CAUSAL || WINDOW) {
#pragma unroll
        for (int r = 0; r < 16; ++r) {
            const int kv0 = kbase + (r & 3) + 8 * (r >> 2) + 4 * hi, kv1 = kv0 + 32;
            bool v0 = true, v1 = true;
            if (CAUSAL) { v0 = kv0 <= qpos; v1 = kv1 <= qpos; }
            if (WINDOW) { v0 = v0 && (qpos - kv0 < 128); v1 = v1 && (qpos - kv1 < 128); }
            p0[r] = v0 ? p0[r] : -INFINITY; p1[r] = v1 ? p1[r] : -INFINITY;
        }
    }
    asm volatile("s_nop 15\n\ts_nop 7" : "+v"(p0), "+v"(p1));
    float mxa = max3f(p0[0], p1[0], p0[1]), mxb = max3f(p1[1], p0[2], p1[2]);
#pragma unroll
    for (int r = 3; r < 15; r += 2) { mxa = max3f(mxa, p0[r], p1[r]); mxb = max3f(mxb, p0[r + 1], p1[r + 1]); }
    mxa = max3f(mxa, p0[15], p1[15]);
    const float mx = xhalf_max(max2f(mxa, mxb));
    bf16x8 va[4], vb[4];
#pragma unroll
    for (int g = 0; g < 4; ++g) {
        const LAS unsigned char* vp = Vt + (32 * (g & 1) + r32) * VT_PITCH + (16 * (g >> 1) + 4 * hi) * 2;
        const s16x4 lo = *(const LAS s16x4*)vp, h4 = *(const LAS s16x4*)(vp + 16), lo2 = *(const LAS s16x4*)(vp + 64), h42 = *(const LAS s16x4*)(vp + 80);
        va[g] = (bf16x8){lo[0], lo[1], lo[2], lo[3], h4[0], h4[1], h4[2], h4[3]};
        vb[g] = (bf16x8){lo2[0], lo2[1], lo2[2], lo2[3], h42[0], h42[1], h42[2], h42[3]};
    }
    const float mn = max2f(m, mx);
    if (__any(mn > m)) {
        const float alpha = __builtin_amdgcn_exp2f((m - mn) * LOG2E);
        l *= alpha;
#pragma unroll
        for (int r = 0; r < 16; ++r) { o[0][r] *= alpha; o[1][r] *= alpha; }
    }
    m = mn;
    const float nm2 = -mn * LOG2E;
    float rs = 0.f;
#pragma unroll
    for (int r = 0; r < 16; ++r) { p0[r] = __builtin_amdgcn_exp2f(__builtin_fmaf(p0[r], LOG2E, nm2)); rs += p0[r]; }
    v4u pw0, pw1;
    pw0.x = cvtpk(p0[0], p0[1]); pw0.y = cvtpk(p0[2], p0[3]); pw0.z = cvtpk(p0[4], p0[5]); pw0.w = cvtpk(p0[6], p0[7]);
    pw1.x = cvtpk(p0[8], p0[9]); pw1.y = cvtpk(p0[10], p0[11]); pw1.z = cvtpk(p0[12], p0[13]); pw1.w = cvtpk(p0[14], p0[15]);
    __builtin_amdgcn_sched_barrier(0);
#pragma unroll
    for (int g = 0; g < 4; ++g) {
        o[g & 1] = __builtin_amdgcn_mfma_f32_32x32x16_bf16(va[g], __builtin_bit_cast(bf16x8, (g >> 1) ? pw1 : pw0), o[g & 1], 0, 0, 0);
#pragma unroll
        for (int e = 0; e < 4; ++e) { p1[4 * g + e] = __builtin_amdgcn_exp2f(__builtin_fmaf(p1[4 * g + e], LOG2E, nm2)); rs += p1[4 * g + e]; }
        __builtin_amdgcn_sched_barrier(0);
    }
    l += rs;
    pw0.x = cvtpk(p1[0], p1[1]); pw0.y = cvtpk(p1[2], p1[3]); pw0.z = cvtpk(p1[4], p1[5]); pw0.w = cvtpk(p1[6], p1[7]);
    pw1.x = cvtpk(p1[8], p1[9]); pw1.y = cvtpk(p1[10], p1[11]); pw1.z = cvtpk(p1[12], p1[13]); pw1.w = cvtpk(p1[14], p1[15]);
#pragma unroll
    for (int g = 0; g < 4; ++g) o[g & 1] = __builtin_amdgcn_mfma_f32_32x32x16_bf16(vb[g], __builtin_bit_cast(bf16x8, (g >> 1) ? pw1 : pw0), o[g & 1], 0, 0, 0);
}
__device__ __forceinline__ void attn_store(const f32x16* o, float l, bf16* orow, int hi) {
    l += __shfl_xor(l, 32);
    const float inv = 1.0f / l;
#pragma unroll
    for (int db = 0; db < 2; ++db)
#pragma unroll
        for (int g = 0; g < 4; ++g) { v2u w; w.x = cvtpk(o[db][4 * g] * inv, o[db][4 * g + 1] * inv); w.y = cvtpk(o[db][4 * g + 2] * inv, o[db][4 * g + 3] * inv);
            *(v2u*)(orow + 32 * db + 8 * g + 4 * hi) = w; }
}
__device__ __forceinline__ void stage_rows(int tid, int& rowA, int& rowB) { if (tid < 256) { rowA = tid >> 3; rowB = rowA + 32; } else { rowA = 2 * ((tid - 256) >> 3); rowB = rowA + 1; } }
__device__ __forceinline__ void stage_write(LAS unsigned char* buf, v4u ra, v4u rb, int tid) {
    const int c = tid & 7;
    if (tid < 256) { const int r = tid >> 3; *(LAS v4u*)(buf + r * KS_PITCH + c * 16) = ra; *(LAS v4u*)(buf + (r + 32) * KS_PITCH + c * 16) = rb; }
    else { const int p = (tid - 256) >> 3; LAS unsigned* vp = (LAS unsigned*)(buf + OFF_VT + (c * 8) * VT_PITCH + p * 4);
        vp[0 * 34] = (ra.x & 0xffffu) | (rb.x << 16); vp[1 * 34] = (ra.x >> 16) | (rb.x & 0xffff0000u);
        vp[2 * 34] = (ra.y & 0xffffu) | (rb.y << 16); vp[3 * 34] = (ra.y >> 16) | (rb.y & 0xffff0000u);
        vp[4 * 34] = (ra.z & 0xffffu) | (rb.z << 16); vp[5 * 34] = (ra.z >> 16) | (rb.z & 0xffff0000u);
        vp[6 * 34] = (ra.w & 0xffffu) | (rb.w << 16); vp[7 * 34] = (ra.w >> 16) | (rb.w & 0xffff0000u); }
}

__device__ __forceinline__ void swa_attn_phase(const bf16* QKV, const float* sinks, bf16* AO, LAS unsigned char* lds, int vcu, int G) {
    const int tid = opaque_tid();
    const int lane = tid & 63, wave = __builtin_amdgcn_readfirstlane(tid >> 6), r32 = lane & 31, hi = lane >> 5;
    int rowA, rowB; stage_rows(tid, rowA, rowB);
    constexpr int NCHUNK = BATCH * KVH * 16;
    for (int rep = 0; rep < PROBE_SWAREP; ++rep)
    for (int ch = vcu; ch < NCHUNK; ch += G) {
        const int b = ch >> 7, kvh = (ch >> 4) & 7, Q0 = (ch & 15) * 8;
        const int head = kvh * 4 + (wave >> 1);
        const float sink = sinks[head];
        const int colkv = (tid < 256 ? 2048 : 2560) + kvh * 64 + (tid & 7) * 8;
        const bf16* gA = QKV + ((size_t)b * SEQ + rowA) * N_SWA_IN + colkv;
        const bf16* gB = QKV + ((size_t)b * SEQ + rowB) * N_SWA_IN + colkv;
        const bf16* Qb = QKV + ((size_t)b * SEQ + 32 * (wave & 1) + r32) * N_SWA_IN + head * 64 + hi * 8;
        const int Tfirst = Q0 >= 2 ? Q0 - 2 : 0, Tlast = Q0 + 7;
        v4u ra = *(const v4u*)(gA + (size_t)Tfirst * 64 * N_SWA_IN), rb = *(const v4u*)(gB + (size_t)Tfirst * 64 * N_SWA_IN);
        v4u qn[4];
#pragma unroll
        for (int d0 = 0; d0 < 4; ++d0) qn[d0] = *(const v4u*)(Qb + (size_t)Q0 * 64 * N_SWA_IN + d0 * 16);
        __syncthreads();
        for (int T = Tfirst; T <= Tlast; ++T) {
            stage_write(lds + (T & 3) * ABUF, ra, rb, tid);
            if (T < Tlast) { ra = *(const v4u*)(gA + (size_t)(T + 1) * 64 * N_SWA_IN); rb = *(const v4u*)(gB + (size_t)(T + 1) * 64 * N_SWA_IN); }
            __syncthreads();
            if (T >= Q0) {
                bf16x8 qr[4];
#pragma unroll
                for (int d0 = 0; d0 < 4; ++d0) qr[d0] = scale_q(qn[d0]);
                if (T < Tlast) {
#pragma unroll
                    for (int d0 = 0; d0 < 4; ++d0) qn[d0] = *(const v4u*)(Qb + (size_t)(T + 1) * 64 * N_SWA_IN + d0 * 16);
                }
                const int qpos = T * 64 + 32 * (wave & 1) + r32;
                f32x16 o[2];
#pragma unroll
                for (int r = 0; r < 16; ++r) { o[0][r] = 0.f; o[1][r] = 0.f; }
                float m = sink, l = hi ? 0.f : 1.f;
                attn_tile<0, false>(lds + (T & 3) * ABUF, qr, o, m, l, qpos, T * 64, r32, hi, true);
                if (T >= 1) attn_tile<0, false>(lds + ((T - 1) & 3) * ABUF, qr, o, m, l, qpos, (T - 1) * 64, r32, hi, false);
                if (T >= 2) attn_tile<0, true>(lds + ((T - 2) & 3) * ABUF, qr, o, m, l, qpos, (T - 2) * 64, r32, hi, false);
                attn_store(o, l, AO + ((size_t)b * SEQ + qpos) * DM + head * 64, hi);
            }
        }
    }
    __syncthreads();
}

template <int VAR>
__device__ __forceinline__ void fox_attn_phase(const bf16* QKV, const float* CUM, const float* KPART, bf16* AO, int* JST, unsigned* Q, LAS unsigned char* lds, int vcu, int G) {
    const int tid = opaque_tid();
    const int lane = tid & 63, wave = __builtin_amdgcn_readfirstlane(tid >> 6), r32 = lane & 31, hi = lane >> 5;
    int rowA, rowB; stage_rows(tid, rowA, rowB);
    volatile LAS unsigned* flags = (volatile LAS unsigned*)(lds + 2 * ABUF);
    constexpr int NUNIT = BATCH * NH * (SEQ / 256);
    volatile LAS int* uq = (volatile LAS int*)(lds + 2 * ABUF + 64);
    if (tid == 0) uq[0] = (int)__hip_atomic_fetch_add(Q, 1u, __ATOMIC_RELAXED, __HIP_MEMORY_SCOPE_AGENT);
    __syncthreads();
    int ui = uq[0];
    while (ui < NUNIT) {
        int unext = 0;
        if (tid == 0) unext = (int)__hip_atomic_fetch_add(Q, 1u, __ATOMIC_RELAXED, __HIP_MEMORY_SCOPE_AGENT);
        const int bh = (ui & 255) >> 2, qb = 31 - (4 * (ui >> 8) + (ui & 3));
        const int b = bh >> 5, h = bh & 31;
        const int q0 = qb * 256, R = q0 + wave * 32, qpos = R + r32;
        const size_t tok = (size_t)b * SEQ + qpos;
        const bf16* Qp = QKV + tok * N_FOX_MAIN + h * 64 + hi * 8;
        bf16x8 qr[4]; float qn2 = 0.f;
#pragma unroll
        for (int d0 = 0; d0 < 4; ++d0) { const v4u w = *(const v4u*)(Qp + d0 * 16); const unsigned ww[4] = {w.x, w.y, w.z, w.w};
#pragma unroll
            for (int e = 0; e < 4; ++e) { const float x0 = bf2f((unsigned short)(ww[e] & 0xffffu)), x1 = bf2f((unsigned short)(ww[e] >> 16)); qn2 += x0 * x0 + x1 * x1; }
            qr[d0] = scale_q(w); }
        qn2 += __shfl_xor(qn2, 32);
        const float4 kp = *(const float4*)(KPART + bh * 4);
        const float kmax = fmaxf(fmaxf(kp.x, kp.y), fmaxf(kp.z, kp.w)) * 1.001f;
        const float qk_bound = 0.125f * sqrtf(qn2) * 1.001f * kmax;
        const float* cum = CUM + (size_t)bh * SEQ;
        const float cref = cum[q0];
        f32x16 o[2];
#pragma unroll
        for (int r = 0; r < 16; ++r) { o[0][r] = 0.f; o[1][r] = 0.f; }
        float m = -INFINITY, l = 0.f;
        const int jmax = 4 * qb + 3, jw = (R + 31) >> 6;
        int jstop = -1;
        const int colkv = (tid < 256 ? 2048 : 4096) + h * 64 + (tid & 7) * 8;
        const bf16* gA = QKV + ((size_t)b * SEQ + rowA) * N_FOX_MAIN + colkv;
        const bf16* gB = QKV + ((size_t)b * SEQ + rowB) * N_FOX_MAIN + colkv;
        const bool brole = (tid >= 256 && tid < 320);
        v4u ra = *(const v4u*)(gA + (size_t)jmax * 64 * N_FOX_MAIN), rb = *(const v4u*)(gB + (size_t)jmax * 64 * N_FOX_MAIN);
        float breg = brole ? cum[jmax * 64 + (tid - 256)] : 0.f;
        float cend = cum[jmax * 64 + 63], cend_n = cend;
        __syncthreads();
        if (tid < 3) flags[tid] = 0u;
        stage_write(lds + (jmax & 1) * ABUF, ra, rb, tid);
        if (brole) ((LAS float*)(lds + (jmax & 1) * ABUF + OFF_BS))[tid - 256] = cref - breg;
        if (jmax > 0) { ra = *(const v4u*)(gA + (size_t)(jmax - 1) * 64 * N_FOX_MAIN); rb = *(const v4u*)(gB + (size_t)(jmax - 1) * 64 * N_FOX_MAIN); if (brole) breg = cum[(jmax - 1) * 64 + (tid - 256)]; cend_n = cum[(jmax - 1) * 64 + 63]; }
        for (int j = jmax; j >= 0; --j) {
            bool need = true;
            if (VAR == 0) { if (j <= jw) { const float U = qk_bound + (cref - cend); need = !__all(((U - m) * LOG2E) < -130.0f); } }
            else need = j > jstop;
            if (j != jmax && need && lane == 0) flags[j % 3] = 1u;
            __syncthreads();
            if (j != jmax && flags[j % 3] == 0u) { jstop = j; break; }
            if (VAR == 1) __builtin_amdgcn_s_sleep(127);
            if (tid == 0) flags[(j + 1) % 3] = 0u;
            if (j > 0) {
                stage_write(lds + ((j - 1) & 1) * ABUF, ra, rb, tid);
                if (brole) ((LAS float*)(lds + ((j - 1) & 1) * ABUF + OFF_BS))[tid - 256] = cref - breg;
                cend = cend_n;
                if (j > 1) { ra = *(const v4u*)(gA + (size_t)(j - 2) * 64 * N_FOX_MAIN); rb = *(const v4u*)(gB + (size_t)(j - 2) * 64 * N_FOX_MAIN); if (brole) breg = cum[(j - 2) * 64 + (tid - 256)]; cend_n = cum[(j - 2) * 64 + 63]; }
            }
            if (VAR == 0 && j <= jw && need) {
                attn_tile<1, false>(lds + (j & 1) * ABUF, qr, o, m, l, qpos, j * 64, r32, hi, j * 64 + 63 > R);
            }
        }
        attn_store(o, l, AO + tok * DM + h * 64, hi);
        if (tid == 0) uq[0] = unext;
        __syncthreads();
        ui = uq[0];
    }
    __syncthreads();
}

__device__ __forceinline__ void fox_cumsum_phase(const float* GATE, const float* bfv, float* CUM, const bf16* QKV, float* KPART, LAS unsigned char* lds) {
    const int tid = opaque_tid();
    const int lane = tid & 63, wave = tid >> 6;
    LAS double* wtot = (LAS double*)lds;
    { LAS float* wmax = (LAS float*)(lds + 256);
      for (int u = blockIdx.x; u < BATCH * NH * 4; u += gridDim.x) {
        const int bh = u >> 2, qtr = u & 3, b = bh >> 5, h = bh & 31;
        float mx = 0.f;
        for (int i = 0; i < 4; ++i) {
            const bf16* kp = QKV + ((size_t)b * SEQ + qtr * 2048 + i * 512 + tid) * N_FOX_MAIN + 2048 + h * 64;
            float ss = 0.f;
#pragma unroll
            for (int c = 0; c < 8; ++c) { const v4u w = *(const v4u*)(kp + c * 8); const unsigned ww[4] = {w.x, w.y, w.z, w.w};
#pragma unroll
                for (int e = 0; e < 4; ++e) { const float x0 = bf2f((unsigned short)(ww[e] & 0xffffu)), x1 = bf2f((unsigned short)(ww[e] >> 16)); ss += x0 * x0 + x1 * x1; } }
            mx = fmaxf(mx, ss);
        }
#pragma unroll
        for (int o = 1; o < 64; o <<= 1) mx = fmaxf(mx, __shfl_xor(mx, o));
        __syncthreads();
        if (lane == 0) wmax[wave] = mx;
        __syncthreads();
        if (tid == 0) { float t = wmax[0]; for (int w = 1; w < NWAVES; ++w) t = fmaxf(t, wmax[w]); KPART[u] = sqrtf(t); }
      }
      __syncthreads(); }
    for (int u = blockIdx.x; u < BATCH * NH; u += gridDim.x) {
        const int b = u >> 5, h = u & 31; const float bb = bfv[h];
        const float* gp = GATE + ((size_t)b * SEQ + tid * 16) * 32 + h;
        float v[16]; double acc = 0.0;
#pragma unroll
        for (int i = 0; i < 16; ++i) { const float z = gp[i * 32] + bb; const float lf = fminf(z, 0.f) - log1pf(expf(-fabsf(z))); acc += (double)lf; v[i] = (float)acc; }
        double incl = acc;
#pragma unroll
        for (int o = 1; o < 64; o <<= 1) { const double t = __shfl_up(incl, o); if (lane >= o) incl += t; }
        __syncthreads();
        if (lane == 63) wtot[wave] = incl;
        __syncthreads();
        double base = incl - acc;
        for (int w = 0; w < wave; ++w) base += wtot[w];
        float* cp = CUM + (size_t)u * SEQ + tid * 16;
#pragma unroll
        for (int i = 0; i < 16; ++i) cp[i] = (float)(base + (double)v[i]);
    }
    __syncthreads();
}

typedef __attribute__((address_space(1))) unsigned gu32;
#define XB_TMO      128
#define XB_XCNT(j)  (256  + 64 * (j))
#define XB_XSUB(j)  (1280 + 64 * (j))
#define XB_XGEN(j)  (2304 + 64 * (j))
#define XB_TOP      3328
#define XB_TOPGEN   3392
#define XCD_BAR_WORDS 3456
#define XB_SPIN_CAP (1u << 18)

__device__ __forceinline__ unsigned xb_ld(unsigned* p)              { return __hip_atomic_load(p, __ATOMIC_RELAXED, __HIP_MEMORY_SCOPE_AGENT); }
__device__ __forceinline__ unsigned xb_add(unsigned* p, unsigned v) { return __hip_atomic_fetch_add(p, v, __ATOMIC_RELAXED, __HIP_MEMORY_SCOPE_AGENT); }
__device__ __forceinline__ unsigned xb_xcc_id() { return (unsigned)__builtin_amdgcn_s_getreg((3 << 11) | 20) & 0xFu; }
#define XB_SPIN(cond, bar) do { unsigned _sp = 0; while (cond) { __builtin_amdgcn_s_sleep(1); \
    if ((++_sp & 255u) == 0u) { if (xb_ld(&(bar)[XB_TMO])) break; if (_sp > XB_SPIN_CAP) { atomicAdd(&(bar)[XB_TMO], 1u); break; } } } } while (0)

struct XcdBarrier {
    unsigned* bar; unsigned x;
    volatile LAS unsigned* st;
};

__device__ __forceinline__ XcdBarrier xcd_barrier_post(unsigned* bar, volatile LAS unsigned* st) {
    XcdBarrier b; b.bar = bar; b.x = xb_xcc_id(); b.st = st;
    if (threadIdx.x == 0) (void)xb_add(&bar[XB_XCNT(b.x)], 1u);
    return b;
}
__device__ __forceinline__ void xcd_barrier_complete(unsigned* bar, unsigned x, unsigned& nloc, unsigned& nx) {
    const unsigned G = gridDim.x * gridDim.y * gridDim.z;
    unsigned sum, cnt, mine, sp = 0u;
    for (;;) {
        sum = 0u; cnt = 0u; mine = 0u;
#pragma unroll
        for (unsigned j = 0; j < 16; ++j) { const unsigned c = xb_ld(&bar[XB_XCNT(j)]); sum += c; cnt += (c > 0u) ? 1u : 0u; mine = (j == x) ? c : mine; }
        if (sum == G) break;
        __builtin_amdgcn_s_sleep(1);
        if ((++sp & 255u) == 0u) { if (xb_ld(&bar[XB_TMO])) break; if (sp > XB_SPIN_CAP) { atomicAdd(&bar[XB_TMO], 1u); break; } }
    }
    nloc = mine > 0u ? mine : 1u; nx = cnt > 0u ? cnt : 1u;
}

__device__ __forceinline__ void xcd_barrier(const XcdBarrier& b) {
    asm volatile("s_waitcnt vmcnt(0)" ::: "memory");
    __syncthreads();
    if (threadIdx.x == 0) {
        unsigned* bar = b.bar;
        __builtin_amdgcn_s_waitcnt(0);
        unsigned nloc = b.st[0], nx = b.st[1];
        if (nloc == 0u) { xcd_barrier_complete(bar, b.x, nloc, nx); b.st[0] = nloc; b.st[1] = nx; }
        const unsigned old = xb_add(&bar[XB_XSUB(b.x)], 1u);
        const unsigned gen = old / nloc;
        if (old + 1u == (gen + 1u) * nloc) {
            __builtin_amdgcn_fence(__ATOMIC_RELEASE, "agent");
            asm volatile("s_waitcnt vmcnt(0)" ::: "memory");
            const unsigned og = xb_add(&bar[XB_TOP], 1u);
            const unsigned tg = og / nx;
            if (og + 1u == (tg + 1u) * nx) xb_add(&bar[XB_TOPGEN], 1u);
            else XB_SPIN(xb_ld(&bar[XB_TOPGEN]) == tg, bar);
            __builtin_amdgcn_fence(__ATOMIC_ACQUIRE, "agent");
            xb_add(&bar[XB_XGEN(b.x)], 1u);
            asm volatile("s_waitcnt vmcnt(0)" ::: "memory");
        } else {
            XB_SPIN(xb_ld(&bar[XB_XGEN(b.x)]) == gen, bar);
            __builtin_amdgcn_fence(__ATOMIC_ACQUIRE, "agent");
            asm volatile("s_waitcnt vmcnt(0)" ::: "memory");
        }
    }
    __syncthreads();
}

struct Args { const float* x; const int* pos; const float* gains; const float* swa_w_in; const float* swa_sinks; const float* swa_w_out; const float* fox_w_in; const float* fox_b_f; const float* fox_w_out;
              const float* w_gu; const float* w_dn; float* out; unsigned char* ws; };

__global__ void __launch_bounds__(NWAVES * 64, 2) mega_fwd(Args a) {
    extern __shared__ __attribute__((aligned(16))) unsigned char lds_raw[];
    cg::grid_group grid = cg::this_grid();
    LAS unsigned char* lds = (LAS unsigned char*)lds_raw;
    const int G = gridDim.x, bx = blockIdx.x;
    const int vcu = (G % 8 == 0) ? (bx % 8) * (G / 8) + bx / 8 : bx;
    const int NGW = G * NWAVES;
    unsigned char* ws = a.ws;
    bf16* WSI = (bf16*)(ws + WS_WSI); bf16* WSO = (bf16*)(ws + WS_WSO); bf16* WFI = (bf16*)(ws + WS_WFI); bf16* WFO = (bf16*)(ws + WS_WFO); bf16* WGU = (bf16*)(ws + WS_WGU); bf16* WDN = (bf16*)(ws + WS_WDN);
    bf16* XN = (bf16*)(ws + WS_XN); bf16* QKV = (bf16*)(ws + WS_QKV); bf16* HB = (bf16*)(ws + WS_HB); bf16* AO = (bf16*)(ws + WS_AO);
    float* Y = (float*)(ws + WS_Y); float* ROPE = (float*)(ws + WS_ROPE); float* GATE = (float*)(ws + WS_GATE); float* CUM = (float*)(ws + WS_CUM);

    volatile LAS unsigned* MISC = (volatile LAS unsigned*)(lds + MISC_OFF);
    if (threadIdx.x < 32) MISC[threadIdx.x] = 0u;
    if (bx == 0) { for (int u = threadIdx.x; u < 4096 + 128; u += NWAVES * 64) ((unsigned*)(ws + WS_CTL))[u] = 0u; }
    for (int prorep = 0; prorep < PROBE_PROREP; ++prorep) {
        const int tid = opaque_tid(), lane = tid & 63, wave = __builtin_amdgcn_readfirstlane(tid >> 6), gw = vcu * NWAVES + wave;
        LAS float* scr = (LAS float*)(lds + wave * 16384);
        transpose_family<false>(a.swa_w_in, 2, DM, N_SWA_IN, WSI, (size_t)N_SWA_IN * DM, scr, gw, NGW, lane);
        transpose_family<false>(a.swa_w_out, 2, DM, DM, WSO, (size_t)DM * DM, scr, gw, NGW, lane);
        transpose_family<false>(a.fox_w_in, 2, DM, N_FOX_IN, WFI, (size_t)N_FOX_PAD * DM, scr, gw, NGW, lane);
        transpose_family<false>(a.fox_w_out, 2, DM, DM, WFO, (size_t)DM * DM, scr, gw, NGW, lane);
        transpose_family<true>(a.w_gu, 4, DM, N_GU, WGU, (size_t)N_GU * DM, scr, gw, NGW, lane);
        transpose_family<false>(a.w_dn, 4, DFF, DM, WDN, (size_t)DM * DFF, scr, gw, NGW, lane);
        for (int it = gw * 64 + lane; it < 2 * 57344; it += NGW * 64) { const int mi = it / 57344, r = it % 57344;
            *(v4u*)(WFI + (size_t)mi * N_FOX_PAD * DM + (size_t)N_FOX_IN * DM + (size_t)r * 8) = (v4u){0u, 0u, 0u, 0u}; }
        for (int it = gw * 64 + lane; it < M * 8; it += NGW * 64) { const int tk = it >> 3, i = it & 7;
            const float inv = powf(500000.0f, -(float)i * 0.125f); const float ang = (float)a.pos[tk] * inv;
            const double rev = (double)ang * 0.15915494309189535; const double fr = rev - rint(rev); const float rad = (float)(fr * 6.283185307179586);
            ROPE[it] = cosf(rad); ROPE[(size_t)M * 8 + it] = sinf(rad); }
        prenorm_rows(a.x, a.gains, XN, vcu, NGW);
    }
    grid.sync();
    const XcdBarrier bar = xcd_barrier_post((unsigned*)(ws + WS_CTL), MISC + 8);

    for (int it = 0; it < 8 * DEPTH + PROBE_DUP; ++it) {
        const int ph = (PROBE_DUP && it > PROBE_PH) ? it - 1 : it;
        const int layer = ph >> 3, st = ph & 7, fox = layer & 1, j = layer >> 1;
        if (st == 1 && !fox) continue;
        const __attribute__((address_space(4))) Args* ka = (const __attribute__((address_space(4))) Args*)__builtin_amdgcn_kernarg_segment_ptr();
        asm volatile("" : "+s"(ka));
        unsigned char* ws = ka->ws;
        const int nrep = (st == PROBE_ST && (layer & 1) == PROBE_LAYER) ? 2 : 1;
        for (int rep = 0; rep < nrep; ++rep) {
        if (st == 0 || st == 3 || st == 5 || st == 6) {
            size_t aoff, boff, ooff; int N, K, mode, ldc, ntm = 1 << 30;
            if (st == 0) { aoff = WS_XN; ooff = WS_QKV; K = DM; mode = 0;
                if (!fox) { boff = WS_WSI + (size_t)j * N_SWA_IN * DM * 2; N = N_SWA_IN; ldc = N_SWA_IN; }
                else { boff = WS_WFI + (size_t)j * N_FOX_PAD * DM * 2; N = N_FOX_PAD; ldc = N_FOX_MAIN; ntm = N_FOX_MAIN / 256; } }
            else if (st == 3) { aoff = WS_AO; boff = (fox ? WS_WFO : WS_WSO) + (size_t)j * DM * DM * 2; ooff = WS_Y; N = DM; K = DM; mode = 1; ldc = DM; }
            else if (st == 5) { aoff = WS_XN; boff = WS_WGU + (size_t)layer * N_GU * DM * 2; ooff = WS_HB; N = N_GU; K = DM; mode = 2; ldc = DFF; }
            else { aoff = WS_HB; boff = WS_WDN + (size_t)layer * DM * DFF * 2; ooff = WS_Y; N = DM; K = DFF; mode = 1; ldc = DM; }
            pg8::Gemm gm{(const bf16*)(ws + aoff), (const bf16*)(ws + boff), M, N, K}; pg8::StaticOrder S; S.init(M, N, G, bx);
            pg8::EpiAny E{mode, true, ws + ooff, ldc, ntm, (float*)(ws + ((st == 0 && !fox) ? WS_ROPE : WS_GATE))};
            pg8::gemm_phase<pg8::EpiAny, pg8::StaticOrder, PG8_ALIGN, PG8_SP2>(lds, gm, S, E);
        } else if (st == 1) {
            fox_cumsum_phase((const float*)(ws + WS_GATE), ka->fox_b_f + j * NH, (float*)(ws + WS_CUM), (const bf16*)(ws + WS_QKV), (float*)(ws + WS_KPART), lds);
        } else if (st == 2) {
            if (!fox) swa_attn_phase((const bf16*)(ws + WS_QKV), ka->swa_sinks + j * NH, (bf16*)(ws + WS_AO), lds, vcu, G);
            else { fox_attn_phase<0>((const bf16*)(ws + WS_QKV), (const float*)(ws + WS_CUM), (const float*)(ws + WS_KPART), (bf16*)(ws + WS_AO), (int*)(ws + WS_KPART + 65536), (unsigned*)(ws + WS_CTL) + 4096 + 64 * j, lds, vcu, G);
                   }
        } else {
            const float* g = ka->gains + (size_t)layer * 4 * DM + (st == 4 ? DM : 3 * DM);
            float* outp = ka->out; const float* Xsrc = (ph == 4) ? ka->x : outp;
            post_rows(Xsrc, (const bf16*)(ws + WS_Y), g, g + DM, outp, (bf16*)(ws + WS_XN), ph != 8 * DEPTH - 1, vcu, NGW);
        }
        }
        if (it != 8 * DEPTH + PROBE_DUP - 1) { for (int r = 0; r < PROBE_NSYNC; ++r) xcd_barrier(bar); }
    }
}

extern "C" void kernel_launch(void* const* d_in, const int* in_sizes, int n_in, void* d_out, int out_size, void* d_ws, size_t ws_size, hipStream_t stream) {
    static int grid = 0;
    if (grid == 0) {
        if (n_in != 11 || in_sizes[0] != M * DM || out_size != M * DM || ws_size < WS_END) { fprintf(stderr, "kernel_launch: unexpected shapes (n_in %d, in0 %d, out %d, ws %zu); nothing launched\n", n_in, n_in > 0 ? in_sizes[0] : -1, out_size, ws_size); grid = -1; return; }
        int dev = 0, cus = 0, per_cu = 0;
        if (hipGetDevice(&dev) != hipSuccess || hipDeviceGetAttribute(&cus, hipDeviceAttributeMultiprocessorCount, dev) != hipSuccess) { grid = -1; return; }
        if (hipFuncSetAttribute((const void*)mega_fwd, hipFuncAttributeMaxDynamicSharedMemorySize, LDS_BYTES) != hipSuccess) { fprintf(stderr, "kernel_launch: hipFuncSetAttribute failed\n"); grid = -1; return; }
        if (hipOccupancyMaxActiveBlocksPerMultiprocessor(&per_cu, (const void*)mega_fwd, NWAVES * 64, LDS_BYTES) != hipSuccess || per_cu < 1) { fprintf(stderr, "kernel_launch: occupancy query says %d\n", per_cu); per_cu = 1; }
        (void)hipGetLastError();
        grid = cus * per_cu;
    }
    if (grid < 0) return;
    Args a{};
    a.x = (const float*)d_in[0]; a.pos = (const int*)d_in[1]; a.gains = (const float*)d_in[2]; a.swa_w_in = (const float*)d_in[3]; a.swa_sinks = (const float*)d_in[4]; a.swa_w_out = (const float*)d_in[5];
    a.fox_w_in = (const float*)d_in[6]; a.fox_b_f = (const float*)d_in[7]; a.fox_w_out = (const float*)d_in[8]; a.w_gu = (const float*)d_in[9]; a.w_dn = (const float*)d_in[10];
    a.out = (float*)d_out; a.ws = (unsigned char*)d_ws;
    void* args[] = {&a};
    const hipError_t e = hipLaunchCooperativeKernel((const void*)mega_fwd, dim3(grid), dim3(NWAVES * 64), args, LDS_BYTES, stream);
    if (e != hipSuccess) fprintf(stderr, "kernel_launch: cooperative launch failed: %s (grid %d)\n", hipGetErrorString(e), grid);
}
```
